# Optimizing an MI355X kernel written in HIP

```python
import math
import jax, jax.numpy as jnp
from jax import lax
import numpy as np

D_MODEL = 2048
BATCH = 1
SEQ = 16384
DEPTH = 2

GRID_W = 64
CTX_LEN = 256
HEAD_DIM = 128
MIX_W = D_MODEL // 4
N_BRANCH = 4
A_HEADS = MIX_W // HEAD_DIM
A_KV_HEADS = 2
ROPE_THETA = 10000.0
Q_BLOCK = 128
B_HEADS = MIX_W // HEAD_DIM
NA_ROWS = 8
NA_COLS = 16
C_HEADS = 4
C_DV = MIX_W // C_HEADS
C_DK = C_DV // 2
C_GATE_RANK = 16
C_GATE_TAU = 16.0
C_CHUNK = 64
D_CH = MIX_W
HY_EMB = 33
HY_FFN = 64
HY_DECAY_MIN = math.log(1e-2) / 1.5
HY_DECAY_MAX = math.log(1e-2) / 0.3
D_FF = 11 * D_MODEL // 4
NORM_EPS = 1e-6
IN_SPLITS = (A_HEADS * HEAD_DIM, A_KV_HEADS * HEAD_DIM, A_KV_HEADS * HEAD_DIM,
             B_HEADS * HEAD_DIM, B_HEADS * HEAD_DIM, B_HEADS * HEAD_DIM,
             C_HEADS * C_DK, C_HEADS * C_DK, C_HEADS * C_DV, 2 * C_GATE_RANK, C_HEADS * C_DV,
             3 * D_CH,
             N_BRANCH * D_MODEL)
IN_OFFSETS = tuple(int(o) for o in np.cumsum(IN_SPLITS)[:-1])
IN_WIDTH = int(sum(IN_SPLITS))

kernel_name = 'hybrid_flow_backbone'


def rms_norm(x, g):
    xf = x.astype(jnp.float32)
    y = xf * lax.rsqrt(jnp.mean(xf * xf, axis=-1, keepdims=True) + NORM_EPS)
    return (y * g.astype(jnp.float32)).astype(x.dtype)


def split_heads(t, n_heads):
    return t.reshape(t.shape[:-1] + (n_heads, t.shape[-1] // n_heads))


def merge_heads(t):
    return t.reshape(t.shape[:-2] + (t.shape[-2] * t.shape[-1],))


def dwconv3(u, w, b):
    up = jnp.pad(u, ((0, 0), (1, 1), (0, 0)))
    return up[:, :-2] * w[0] + up[:, 1:-1] * w[1] + up[:, 2:] * w[2] + b


def axial_rope_tables(length):
    pos = jnp.arange(length, dtype=jnp.int32)
    axes = jnp.stack([pos // GRID_W, pos % GRID_W], axis=-1).astype(jnp.float32)
    quarter = HEAD_DIM // 4
    inv_freq = ROPE_THETA ** (-jnp.arange(quarter, dtype=jnp.float32) / quarter)
    ang = axes[:, :, None] * inv_freq
    return jnp.cos(ang), jnp.sin(ang)


def apply_axial_rope(x, cos, sin):
    xs = x.reshape(x.shape[:-1] + (2, 2, HEAD_DIM // 4))
    c = cos[None, :, None].astype(x.dtype)
    s = sin[None, :, None].astype(x.dtype)
    x1, x2 = xs[..., 0, :], xs[..., 1, :]
    return jnp.stack([x1 * c - x2 * s, x2 * c + x1 * s], axis=-2).reshape(x.shape)


def gqa_sdpa(q, k, v):
    b, lq, h, d = q.shape
    kvh = k.shape[2]
    qg = q.reshape(b, lq, kvh, h // kvh, d)
    s = jnp.einsum('bqkgd,bskd->bkgqs', qg, k).astype(jnp.float32) * (d ** -0.5)
    p = jax.nn.softmax(s, axis=-1).astype(v.dtype)
    o = jnp.einsum('bkgqs,bskd->bqkgd', p, v)
    return o.reshape(b, lq, h * d)


def mixer_gqa(q_l, k_l, v_l, q_c, k_c, v_c, qn_g, kn_g, ctx_out):
    b, length = q_l.shape[:2]
    q_l = rms_norm(split_heads(q_l, A_HEADS), qn_g)
    k_l = rms_norm(split_heads(k_l, A_KV_HEADS), kn_g)
    v_l = split_heads(v_l, A_KV_HEADS)
    q_c = rms_norm(split_heads(q_c, A_HEADS), qn_g)
    k_c = rms_norm(split_heads(k_c, A_KV_HEADS), kn_g)
    v_c = split_heads(v_c, A_KV_HEADS)
    cos, sin = axial_rope_tables(length)
    q_l = apply_axial_rope(q_l, cos, sin)
    k_l = apply_axial_rope(k_l, cos, sin)
    keys = jnp.concatenate([k_c, k_l], axis=1)
    vals = jnp.concatenate([v_c, v_l], axis=1)
    nb = length // Q_BLOCK
    qb = q_l.reshape(b, nb, Q_BLOCK, A_HEADS, HEAD_DIM).swapaxes(0, 1)
    o = lax.map(lambda qblk: gqa_sdpa(qblk, keys, vals), qb)
    y_l = o.swapaxes(0, 1).reshape(b, length, A_HEADS * HEAD_DIM)
    y_c = gqa_sdpa(q_c, k_c, v_c) if ctx_out else None
    return y_l, y_c


def neighbourhood_attention(q, k, v, k_c, v_c, rpb):
    b, length, h, d = q.shape
    rows = length // GRID_W
    wr = min(NA_ROWS, rows)
    qg = q.reshape(b, rows, GRID_W, h, d)
    kg = k.reshape(b, rows, GRID_W, h, d)
    vg = v.reshape(b, rows, GRID_W, h, d)
    col = np.arange(GRID_W)
    c_start = np.clip(col - NA_COLS // 2, 0, GRID_W - NA_COLS)
    col_idx = c_start[:, None] + np.arange(NA_COLS)[None, :]
    dc = col_idx - col[:, None] + (NA_COLS - 1)
    bias_cols = rpb[:, :, dc].astype(jnp.float32)
    scale = HEAD_DIM ** -0.5

    def row_block(r):
        rs = jnp.clip(r - wr // 2, 0, rows - wr)
        kw = lax.dynamic_slice_in_dim(kg, rs, wr, axis=1)[:, :, col_idx]
        vw = lax.dynamic_slice_in_dim(vg, rs, wr, axis=1)[:, :, col_idx]
        qr = lax.dynamic_index_in_dim(qg, r, axis=1, keepdims=False)
        dr = rs + jnp.arange(wr) - r + (NA_ROWS - 1)
        bias = jnp.take(bias_cols, dr, axis=1).transpose(0, 2, 1, 3)
        s_loc = jnp.einsum('bqhd,brqjhd->bhqrj', qr, kw).astype(jnp.float32) * scale + bias[None]
        s_ctx = jnp.einsum('bqhd,bchd->bhqc', qr, k_c).astype(jnp.float32) * scale
        s = jnp.concatenate([s_loc.reshape(b, h, GRID_W, wr * NA_COLS), s_ctx], axis=-1)
        p = jax.nn.softmax(s, axis=-1).astype(v.dtype)
        p_loc = p[..., :wr * NA_COLS].reshape(b, h, GRID_W, wr, NA_COLS)
        o = (jnp.einsum('bhqrj,brqjhd->bqhd', p_loc, vw)
             + jnp.einsum('bhqc,bchd->bqhd', p[..., wr * NA_COLS:], v_c))
        return o.reshape(b, GRID_W, h * d)

    out = lax.map(row_block, jnp.arange(rows))
    return out.transpose(1, 0, 2, 3).reshape(b, length, h * d)


def mixer_neighbourhood(q_l, k_l, v_l, q_c, k_c, v_c, rpb, ctx_out):
    k_c = split_heads(k_c, B_HEADS)
    v_c = split_heads(v_c, B_HEADS)
    y_l = neighbourhood_attention(split_heads(q_l, B_HEADS), split_heads(k_l, B_HEADS),
                                  split_heads(v_l, B_HEADS), k_c, v_c, rpb)
    y_c = gqa_sdpa(split_heads(q_c, B_HEADS), k_c, v_c) if ctx_out else None
    return y_l, y_c


def gla_chunked(q, k, v, log_a, s0):
    b, length, h, _ = q.shape
    dv = v.shape[-1]
    n = length // C_CHUNK
    mask = np.tril(np.ones((C_CHUNK, C_CHUNK), dtype=bool))[:, :, None]

    def to_chunks(t):
        return t.reshape(b, n, C_CHUNK, h, t.shape[-1]).transpose(1, 0, 3, 2, 4)

    def step(state, xs):
        qc, kc, vc, gc = xs
        bcum = jnp.cumsum(gc.astype(jnp.float32), axis=2)
        o_inter = jnp.einsum('bhcd,bhde->bhce', qc * jnp.exp(bcum), state)
        diff = bcum[:, :, :, None, :] - bcum[:, :, None, :, :]
        decay = jnp.exp(jnp.where(mask, diff, -jnp.inf))
        att = jnp.einsum('bhid,bhjd,bhijd->bhij', qc, kc, decay)
        o = o_inter + jnp.einsum('bhij,bhje->bhie', att, vc)
        blast = bcum[:, :, -1:, :]
        new_state = (jnp.exp(blast[:, :, 0, :, None]) * state
                     + jnp.einsum('bhjd,bhje->bhde', kc * jnp.exp(blast - bcum), vc))
        return new_state, o

    s_fin, o = lax.scan(step, s0, (to_chunks(q), to_chunks(k), to_chunks(v), to_chunks(log_a)))
    o = o.transpose(1, 0, 3, 2, 4).reshape(b, length, h, dv)
    return o.astype(v.dtype), s_fin


def mixer_gla(q_l, k_l, v_l, a_l, g_l, q_c, k_c, v_c, a_c, g_c, gate_w2, gate_b, norm_g, ctx_out):
    def prep(q, k, v, a):
        q = split_heads(q, C_HEADS) * (C_DK ** -0.5)
        k = split_heads(k, C_HEADS)
        v = split_heads(v, C_HEADS)
        a = a.reshape(a.shape[:-1] + (2, C_GATE_RANK))
        la = jax.nn.log_sigmoid((jnp.einsum('blnr,nrk->blnk', a, gate_w2) + gate_b).astype(jnp.float32)) / C_GATE_TAU
        la = split_heads(la, C_HEADS)
        return q, k, v, la[:, :, 0], la[:, :, 1]

    def flip(t):
        return jnp.flip(t, axis=1)

    qc, kc, vc, fwd_c, bwd_c = prep(q_c, k_c, v_c, a_c)
    ql, kl, vl, fwd_l, bwd_l = prep(q_l, k_l, v_l, a_l)
    s0 = jnp.zeros((q_l.shape[0], C_HEADS, C_DK, C_DV), jnp.float32)
    o_cf, s_f = gla_chunked(qc, kc, vc, fwd_c, s0)
    o_cb, s_b = gla_chunked(flip(qc), flip(kc), flip(vc), flip(bwd_c), s0)
    o_lf, _ = gla_chunked(ql, kl, vl, fwd_l, s_f)
    o_lb, _ = gla_chunked(flip(ql), flip(kl), flip(vl), flip(bwd_l), s_b)

    def head_out(o, g):
        return merge_heads(rms_norm(o, norm_g)) * jax.nn.silu(g)

    y_l = head_out(o_lf + flip(o_lb), g_l)
    y_c = head_out(o_cf + flip(o_cb), g_c) if ctx_out else None
    return y_l, y_c


def hyena_filter(length, w1, b1, w2, b2, w3, b3, w4, freq):
    t = jnp.linspace(0.0, 1.0, length, dtype=jnp.float32)[:, None]
    bands = (HY_EMB - 1) // 2
    w = 2.0 * math.pi * jnp.arange(length, dtype=jnp.float32)[:, None] / length
    f = jnp.linspace(1e-4, bands - 1, bands, dtype=jnp.float32)
    z = jnp.concatenate([t, jnp.cos(f * w), -jnp.sin(f * w)], axis=-1)
    hid = jnp.sin(freq * (z @ w1 + b1))
    hid = jnp.sin(freq * (hid @ w2 + b2))
    hid = jnp.sin(freq * (hid @ w3 + b3))
    h = (hid @ w4).astype(jnp.float32).reshape(length, 2, D_CH)
    deltas = jnp.abs(jnp.linspace(HY_DECAY_MIN, HY_DECAY_MAX, D_CH, dtype=jnp.float32))
    h = h * jnp.exp(-t * deltas)[:, None, :]
    return h / jnp.sum(jnp.abs(h), axis=(0, 1), keepdims=True)


def long_conv_bidir(u, h):
    length = u.shape[1]
    ch = h.shape[-1]
    k2 = jnp.concatenate([h[:, 0], jnp.zeros((1, ch), h.dtype), h[:0:-1, 1]], axis=0)
    kf = jnp.fft.rfft(k2, axis=0)
    uf = jnp.fft.rfft(u.astype(jnp.float32), n=2 * length, axis=1)
    y = jnp.fft.irfft(uf * kf, n=2 * length, axis=1)[:, :length]
    return y.astype(u.dtype)


def mixer_hyena(u_l, u_c, conv_w, conv_b, w1, b1, w2, b2, w3, b3, w4, freq, bias, ctx_out):
    def run(u):
        x0, x1, v = jnp.split(dwconv3(u, conv_w, conv_b), 3, axis=-1)
        z = v * x1
        filt = hyena_filter(u.shape[1], w1, b1, w2, b2, w3, b3, w4, freq)
        return x0 * (long_conv_bidir(z, filt) + z * bias)

    y_l = run(u_l)
    y_c = run(u_c) if ctx_out else None
    return y_l, y_c


def merge_branches(ys, gates, branch_w, w_out):
    g = jax.nn.sigmoid(gates.reshape(gates.shape[:-1] + (N_BRANCH, D_MODEL)))
    merged = g[..., 0, :] * (ys[0] @ branch_w[0])
    for i in range(1, N_BRANCH):
        merged = merged + g[..., i, :] * (ys[i] @ branch_w[i])
    return merged @ w_out


def token_mixing(p_l, p_c, a_qn_g, a_kn_g, b_rpb, c_gate_w2, c_gate_b, c_norm_g,
                 d_conv_w, d_conv_b, d_ffn_w1, d_ffn_b1, d_ffn_w2, d_ffn_b2, d_ffn_w3, d_ffn_b3,
                 d_ffn_w4, d_sin_freq, d_bias, branch_w, w_out, ctx_out):
    aq_l, ak_l, av_l, bq_l, bk_l, bv_l, cq_l, ck_l, cv_l, ca_l, cg_l, du_l, gate_l = jnp.split(p_l, IN_OFFSETS, axis=-1)
    aq_c, ak_c, av_c, bq_c, bk_c, bv_c, cq_c, ck_c, cv_c, ca_c, cg_c, du_c, gate_c = jnp.split(p_c, IN_OFFSETS, axis=-1)
    ya_l, ya_c = mixer_gqa(aq_l, ak_l, av_l, aq_c, ak_c, av_c, a_qn_g, a_kn_g, ctx_out)
    yb_l, yb_c = mixer_neighbourhood(bq_l, bk_l, bv_l, bq_c, bk_c, bv_c, b_rpb, ctx_out)
    yc_l, yc_c = mixer_gla(cq_l, ck_l, cv_l, ca_l, cg_l, cq_c, ck_c, cv_c, ca_c, cg_c,
                           c_gate_w2, c_gate_b, c_norm_g, ctx_out)
    yd_l, yd_c = mixer_hyena(du_l, du_c, d_conv_w, d_conv_b, d_ffn_w1, d_ffn_b1, d_ffn_w2, d_ffn_b2,
                             d_ffn_w3, d_ffn_b3, d_ffn_w4, d_sin_freq, d_bias, ctx_out)
    y_l = merge_branches((ya_l, yb_l, yc_l, yd_l), gate_l, branch_w, w_out)
    y_c = merge_branches((ya_c, yb_c, yc_c, yd_c), gate_c, branch_w, w_out) if ctx_out else None
    return y_l, y_c


def conv_ffn(n, w_up, conv_w, conv_b, w_down):
    u = dwconv3(n @ w_up, conv_w, conv_b)
    a, g = jnp.split(u, 2, axis=-1)
    return (jax.nn.silu(g) * a) @ w_down


def modulate(h, g, shift, scale):
    return rms_norm(h, g) * (1.0 + scale) + shift


def setup_inputs(seed: int = 0) -> dict:
    key = jax.random.key(seed)
    ks = iter(jax.random.split(key, 48))

    def nrm(shape, scale):
        return scale * jax.random.normal(next(ks), shape, jnp.float32)

    def gain(shape):
        return 1.0 + nrm(shape, 0.05)

    L = DEPTH
    return {
        'x': nrm((BATCH, SEQ, D_MODEL), 1.0),
        'c': nrm((BATCH, D_MODEL), 1.0),
        'ctx': nrm((BATCH, CTX_LEN, D_MODEL), 1.0),
        'c_ctx': nrm((D_MODEL,), 1.0),
        'ada_w': nrm((L, D_MODEL, 6 * D_MODEL), 0.5 * D_MODEL ** -0.5),
        'ada_b': nrm((L, 6 * D_MODEL), 0.01),
        'norm1_g': gain((L, D_MODEL)),
        'norm2_g': gain((L, D_MODEL)),
        'w_in': nrm((L, D_MODEL, IN_WIDTH), D_MODEL ** -0.5),
        'a_qn_g': gain((L, HEAD_DIM)),
        'a_kn_g': gain((L, HEAD_DIM)),
        'b_rpb': nrm((L, B_HEADS, 2 * NA_ROWS - 1, 2 * NA_COLS - 1), 0.1),
        'c_gate_w2': nrm((L, 2, C_GATE_RANK, C_HEADS * C_DK), C_GATE_RANK ** -0.5),
        'c_gate_b': nrm((L, 2, C_HEADS * C_DK), 0.1),
        'c_norm_g': gain((L, C_DV)),
        'd_conv_w': nrm((L, 3, 3 * D_CH), 3 ** -0.5),
        'd_conv_b': nrm((L, 3 * D_CH), 0.01),
        'd_ffn_w1': nrm((L, HY_EMB, HY_FFN), HY_EMB ** -0.5),
        'd_ffn_b1': nrm((L, HY_FFN), 0.01),
        'd_ffn_w2': nrm((L, HY_FFN, HY_FFN), HY_FFN ** -0.5),
        'd_ffn_b2': nrm((L, HY_FFN), 0.01),
        'd_ffn_w3': nrm((L, HY_FFN, HY_FFN), HY_FFN ** -0.5),
        'd_ffn_b3': nrm((L, HY_FFN), 0.01),
        'd_ffn_w4': nrm((L, HY_FFN, 2 * D_CH), HY_FFN ** -0.5),
        'd_sin_freq': gain((L, HY_FFN)),
        'd_bias': nrm((L, D_CH), 0.5),
        'branch_w': nrm((L, N_BRANCH, MIX_W, D_MODEL), MIX_W ** -0.5),
        'w_out': nrm((L, D_MODEL, D_MODEL), D_MODEL ** -0.5),
        'ffn_up': nrm((L, D_MODEL, 2 * D_FF), D_MODEL ** -0.5),
        'ffn_conv_w': nrm((L, 3, 2 * D_FF), 3 ** -0.5),
        'ffn_conv_b': nrm((L, 2 * D_FF), 0.01),
        'ffn_down': nrm((L, D_FF, D_MODEL), D_FF ** -0.5),
        'final_norm_g': gain((D_MODEL,)),
    }


def reference(x, c, ctx, c_ctx, ada_w, ada_b, norm1_g, norm2_g, w_in, a_qn_g, a_kn_g, b_rpb,
              c_gate_w2, c_gate_b, c_norm_g, d_conv_w, d_conv_b, d_ffn_w1, d_ffn_b1, d_ffn_w2,
              d_ffn_b2, d_ffn_w3, d_ffn_b3, d_ffn_w4, d_sin_freq, d_bias, branch_w, w_out,
              ffn_up, ffn_conv_w, ffn_conv_b, ffn_down, final_norm_g):
    h_l, h_c = x, ctx
    for i in range(DEPTH):
        ctx_out = i < DEPTH - 1
        mod_l = (jax.nn.silu(c) @ ada_w[i] + ada_b[i])[:, None, :]
        mod_c = jax.nn.silu(c_ctx) @ ada_w[i] + ada_b[i]
        sh1_l, sc1_l, g1_l, sh2_l, sc2_l, g2_l = jnp.split(mod_l, 6, axis=-1)
        sh1_c, sc1_c, g1_c, sh2_c, sc2_c, g2_c = jnp.split(mod_c, 6, axis=-1)
        p_l = modulate(h_l, norm1_g[i], sh1_l, sc1_l) @ w_in[i]
        p_c = modulate(h_c, norm1_g[i], sh1_c, sc1_c) @ w_in[i]
        mix_l, mix_c = token_mixing(p_l, p_c, a_qn_g[i], a_kn_g[i], b_rpb[i], c_gate_w2[i], c_gate_b[i],
                                    c_norm_g[i], d_conv_w[i], d_conv_b[i], d_ffn_w1[i], d_ffn_b1[i],
                                    d_ffn_w2[i], d_ffn_b2[i], d_ffn_w3[i], d_ffn_b3[i], d_ffn_w4[i],
                                    d_sin_freq[i], d_bias[i], branch_w[i], w_out[i], ctx_out)
        h_l = h_l + g1_l * mix_l
        h_l = h_l + g2_l * conv_ffn(modulate(h_l, norm2_g[i], sh2_l, sc2_l),
                                    ffn_up[i], ffn_conv_w[i], ffn_conv_b[i], ffn_down[i])
        if ctx_out:
            h_c = h_c + g1_c * mix_c
            h_c = h_c + g2_c * conv_ffn(modulate(h_c, norm2_g[i], sh2_c, sc2_c),
                                        ffn_up[i], ffn_conv_w[i], ffn_conv_b[i], ffn_down[i])
    return rms_norm(h_l, final_norm_g)
```

```cpp
#include <hip/hip_runtime.h>
#include <hip/hip_cooperative_groups.h>
#include <cstdint>
#include <cstdio>
namespace cg = cooperative_groups;

typedef unsigned short bf16_t;
typedef short bf16x8 __attribute__((ext_vector_type(8)));
typedef short s16x4 __attribute__((ext_vector_type(4)));
typedef float f32x4 __attribute__((ext_vector_type(4)));
typedef float f32x16 __attribute__((ext_vector_type(16)));
typedef unsigned u32x4 __attribute__((ext_vector_type(4)));
typedef unsigned u32x2 __attribute__((ext_vector_type(2)));

constexpr int DM = 2048, SEQ = 16384, CTXL = 256, MALL = SEQ + CTXL, LDP = 14080, NPM = 5888, INW = 13856, NMIX = 5664, DFF = 5632, NUP = 11264;
constexpr int C_AQ = 0, C_AK = 512, C_AV = 768, C_BQ = 1024, C_BK = 1536, C_BV = 2048, C_CQ = 2560, C_CK = 2816, C_CV = 3072, C_CA = 3584, C_CG = 3616, C_DU = 4128;
constexpr int NTH = 512;
constexpr int LDS_BYTES = 135168;
constexpr int KS = 16;
constexpr int NCHUNK = MALL / 64;

constexpr size_t WS_CTL  = 0;
constexpr size_t WS_MODP = 16384;
constexpr size_t WS_MOD  = WS_MODP + (size_t)KS * 2 * 2 * 12288 * 4;
constexpr size_t WS_HC   = WS_MOD + (size_t)2 * 2 * 12288 * 4;
constexpr size_t WS_FSUM = WS_HC + (size_t)CTXL * DM * 4;
constexpr size_t WS_FT   = WS_FSUM + (size_t)2 * 520 * 1024 * 4;
constexpr size_t WS_FTC  = WS_FT + (size_t)2 * 512 * 32768 * 2;
constexpr size_t WS_GD   = WS_FTC + (size_t)2 * 2 * 512 * 256 * 4;
constexpr size_t WS_WIN  = WS_GD + (size_t)8 * NCHUNK * 64 * 4;
constexpr size_t WS_WBR  = WS_WIN + (size_t)LDP * DM * 2;
constexpr size_t WS_WOUT = WS_WBR + (size_t)4 * DM * 512 * 2;
constexpr size_t WS_WUP  = WS_WOUT + (size_t)DM * DM * 2;
constexpr size_t WS_WDN  = WS_WUP + (size_t)NUP * DM * 2;
constexpr size_t WS_P    = WS_WDN + (size_t)DM * DFF * 2;
constexpr size_t WS_XN   = WS_P + (size_t)MALL * LDP * 2;
constexpr size_t WS_YS   = WS_XN + (size_t)MALL * DM * 2;
constexpr size_t WS_MG   = WS_YS + (size_t)4 * MALL * 512 * 2;
constexpr size_t WS_END  = WS_MG + (size_t)MALL * DM * 2;
constexpr size_t WS_U    = WS_P;
constexpr size_t WS_HID  = WS_P + 33554432;
constexpr size_t WS_GS   = WS_XN;
constexpr size_t WS_ZT   = WS_MG;
constexpr size_t WS_X0T  = WS_MG + (size_t)512 * MALL * 2;
static_assert((size_t)8 * NCHUNK * 64 * 128 * 4 <= (size_t)MALL * DM * 2, "GLA states fit XN");
static_assert(33554432 + (size_t)MALL * DFF * 2 <= (size_t)MALL * LDP * 2 && (size_t)(MALL / 64) * 4 * NUP * 2 <= 33554432, "raw + hidden fit the P region");
static_assert((size_t)MALL * NUP * 2 <= (size_t)MALL * LDP * 2, "U fits P");
static_assert(WS_END <= 900000000ull, "workspace budget");

__device__ __forceinline__ float bf2f(bf16_t u) { return __uint_as_float((unsigned)u << 16); }
__device__ __forceinline__ unsigned pk2(float lo, float hi) { unsigned r; asm volatile("v_cvt_pk_bf16_f32 %0, %1, %2" : "=v"(r) : "v"(lo), "v"(hi)); return r; }
__device__ __forceinline__ bf16_t f2bf(float a) { return (bf16_t)(pk2(a, a) & 0xffffu); }
__device__ __forceinline__ float wave_sum(float v) {
#pragma unroll
    for (int o = 1; o < 64; o <<= 1) v += __shfl_xor(v, o);
    return v;
}
__device__ __forceinline__ float sigmoidf_(float x) { return 1.f / (1.f + __expf(-x)); }
__device__ __forceinline__ float siluf_(float x) { return x / (1.f + __expf(-x)); }

__device__ __forceinline__ void sincos_(float x, float& s, float& c) {
    const float kf = rintf(x * 0.6366197723675814f); const int k = (int)kf;
    float r = fmaf(-kf, 1.5703125f, x); r = fmaf(-kf, 4.837512969970703125e-4f, r); r = fmaf(-kf, 7.54978995e-8f, r);
    const float r2 = r * r;
    const float sp = r + r * r2 * (-1.6666654611e-1f + r2 * (8.3321608736e-3f + r2 * (-1.9515295891e-4f)));
    const float cp = 1.f - 0.5f * r2 + r2 * r2 * (4.166664568298827e-2f + r2 * (-1.388731625493765e-3f + r2 * 2.443315711809948e-5f));
    float ss = (k & 1) ? cp : sp, cc = (k & 1) ? sp : cp;
    if (k & 2) ss = -ss;
    if ((k + 1) & 2) cc = -cc;
    s = ss; c = cc;
}
__device__ __forceinline__ float sin_(float x) { float s, c; sincos_(x, s, c); return s; }
__device__ __forceinline__ float cos_(float x) { float s, c; sincos_(x, s, c); return c; }

__device__ __forceinline__ int ltid() { int t = threadIdx.x; asm volatile("" : "+v"(t)); return t; }

__device__ __forceinline__ int lbid() { int b = blockIdx.x; asm volatile("" : "+s"(b)); return b; }

struct Params { const float* in[33]; float* out; unsigned char* ws; int ph_lo, ph_hi; };

namespace pg8 {
#define PG8_LAS __attribute__((address_space(3)))
typedef unsigned short bf16_t;
typedef short bf16x8 __attribute__((ext_vector_type(8)));
typedef float f32x4 __attribute__((ext_vector_type(4)));
typedef unsigned u32x4 __attribute__((ext_vector_type(4)));
constexpr int BM = 256, BK = 64, HALF = 128, HTB = HALF * BK * 2  , STAGE_BYTES = 8 * HTB, NXCD = 8, WGM = 8;

__host__ __device__ __forceinline__ int lds_byte(int r, int c) { const int st = (r >> 4) * 2 + (c >> 5), rr = r & 15, cc = c & 31, ob = rr * 64 + cc * 2; return st * 1024 + (ob ^ (((ob >> 9) & 1) << 5)); }
__host__ __device__ __forceinline__ void stage_rc(int b, int& R, int& C) { const int st = b / 1024, sb = b % 1024, swz = sb ^ (((sb >> 9) & 1) << 5); R = (st >> 1) * 16 + swz / 64; C = (st & 1) * 32 + (swz % 64) / 2; }
__host__ __device__ __forceinline__ int perm32(int rho) { const int n = rho >> 4, i = rho & 15; return 8 * (i >> 2) + 4 * n + (i & 3); }

struct Unit { int pm, pn; };
struct Gemm { const bf16_t* A; const bf16_t* Bt; int M, N, K; };

struct StaticOrder {
    int nM, nN, nwg, G, c;
    __host__ __device__ void init(int M, int N, int G_, int c_) { nM = M / BM; nN = N / BM; nwg = nM * nN; G = G_; c = c_; }
    __host__ __device__ bool next(int i, Unit& u) const {
        const long L = (long)i * G + c; if (L >= nwg) return false;
        int wgid = (int)L; { const int q = nwg / NXCD, r = nwg % NXCD, xcd = wgid % NXCD, off = wgid / NXCD; wgid = (xcd < r ? xcd * (q + 1) : r * (q + 1) + (xcd - r) * q) + off; }
        const int nig = WGM * nN, gid = wgid / nig, fm = gid * WGM, gsz = (nM - fm) < WGM ? (nM - fm) : WGM;
        u.pm = fm + ((wgid % nig) % gsz); u.pn = (wgid % nig) / gsz; return true;
    }
    __device__ __forceinline__ void a_ready(const Unit&) const {}
    __device__ __forceinline__ void done(const Unit&) const {}
};

__device__ __forceinline__ unsigned cvt_pk_bf16(float lo, float hi) { unsigned r; asm volatile("v_cvt_pk_bf16_f32 %0, %1, %2" : "=v"(r) : "v"(lo), "v"(hi)); return r; }

template <class Epi, class Sched, bool ALIGN_EPI = false, bool SP2 = false>
__device__ __forceinline__ void gemm_phase(PG8_LAS unsigned char* lds, const Gemm g, const Sched& S, const Epi& E) {
    const int tid = ltid(), wid = __builtin_amdgcn_readfirstlane(tid >> 6), lane = tid & 63, wr = wid >> 2, wc = wid & 3, fr = lane & 15, fq = lane >> 4;
    const int K = g.K, nt = K / BK;
    unsigned voffA[2], voffB[2];
#pragma unroll
    for (int i = 0; i < 2; ++i) { int R, C; stage_rc(tid * 16 + i * 8192, R, C); const int Rb = Epi::PERM ? ((R & ~31) + perm32(R & 31)) : R;
        voffA[i] = (unsigned)(R * K + C) * 2u; voffB[i] = (unsigned)(Rb * K + C) * 2u; }
    const size_t kstep = (size_t)(BK * 2);
    const size_t hstep = (size_t)HALF * K * 2;
    const size_t tstep = 2 * hstep;
    const unsigned ldsw = (unsigned)wid * 1024u;
    const int aoff = lds_byte(wr * 64 + fr, fq * 8), boff = lds_byte(wc * 32 + fr, fq * 8);
#define PG8_SA(b, h) (((b) * 2 + (h)) * HTB)
#define PG8_SB(b, h) ((4 + (b) * 2 + (h)) * HTB)
#define PG8_STAGE(bufoff, gbase, voff) do { _Pragma("unroll") for (int _i = 0; _i < 2; ++_i) \
        __builtin_amdgcn_global_load_lds((const unsigned*)((const char*)(gbase) + (voff)[_i]), (PG8_LAS unsigned*)(lds + (bufoff) + ldsw + _i * 8192), 16, 0, 0); } while (0)
#define PG8_LDA(dst, b, h) do { _Pragma("unroll") for (int m = 0; m < 4; ++m) _Pragma("unroll") for (int k = 0; k < 2; ++k) dst[m][k] = *(const PG8_LAS bf16x8*)(lds + PG8_SA(b, h) + aoff + m * 2048 + k * 1024); } while (0)
#define PG8_LDB(dst, b, h) do { _Pragma("unroll") for (int n = 0; n < 2; ++n) _Pragma("unroll") for (int k = 0; k < 2; ++k) dst[n][k] = *(const PG8_LAS bf16x8*)(lds + PG8_SB(b, h) + boff + n * 2048 + k * 1024); } while (0)
#define PG8_MMA(ai, bj, At, Bt) do { __builtin_amdgcn_s_setprio(1); _Pragma("unroll") for (int m = 0; m < 4; ++m) _Pragma("unroll") for (int n = 0; n < 2; ++n) _Pragma("unroll") for (int k = 0; k < 2; ++k) \
        acc[ai][bj][m][n] = __builtin_amdgcn_mfma_f32_16x16x32_bf16(Bt[n][k], At[m][k], acc[ai][bj][m][n], 0, 0, 0); __builtin_amdgcn_s_setprio(0); } while (0)
#define PG8_WAIT_V(n) asm volatile("s_waitcnt vmcnt(" #n ")" ::: "memory")
#define PG8_WAIT_L(n) asm volatile("s_waitcnt lgkmcnt(" #n ")" ::: "memory")
#define PG8_BAR __builtin_amdgcn_s_barrier()
#define PG8_SCHED __builtin_amdgcn_sched_barrier(0)
    Unit cur, nxt; int ui = 0;
    if (!S.next(0, cur)) return;
    f32x4 acc[2][2][4][2];
#pragma unroll
    for (int a = 0; a < 2; ++a)
#pragma unroll
        for (int b = 0; b < 2; ++b)
#pragma unroll
            for (int m = 0; m < 4; ++m)
#pragma unroll
                for (int n = 0; n < 2; ++n) { float zr_ = 0.f; asm volatile("" : "+v"(zr_)); acc[a][b][m][n] = (f32x4){zr_, zr_, zr_, zr_}; }
    bf16x8 At[4][2], B0[2][2], B1[2][2];
    const char* cA = (const char*)g.A + (size_t)cur.pm * tstep; const char* cB = (const char*)g.Bt + (size_t)cur.pn * tstep;
    S.a_ready(cur);
    if constexpr (SP2) {
        PG8_STAGE(PG8_SB(0, 0), cB, voffB); PG8_STAGE(PG8_SB(0, 1), cB + hstep, voffB); PG8_STAGE(PG8_SA(0, 0), cA, voffA); PG8_STAGE(PG8_SA(0, 1), cA + hstep, voffA);
        if (wr == 1) PG8_BAR;
        PG8_WAIT_V(2); PG8_BAR;
        PG8_STAGE(PG8_SB(1, 0), cB + kstep, voffB); PG8_STAGE(PG8_SA(1, 0), cA + kstep, voffA); PG8_STAGE(PG8_SB(1, 1), cB + hstep + kstep, voffB);
        PG8_WAIT_V(6); PG8_BAR;
    } else {
        PG8_STAGE(PG8_SB(0, 0), cB, voffB); PG8_STAGE(PG8_SA(0, 0), cA, voffA); PG8_STAGE(PG8_SB(0, 1), cB + hstep, voffB); PG8_STAGE(PG8_SA(0, 1), cA + hstep, voffA);
        if (wr == 1) PG8_BAR;
        PG8_WAIT_V(4); PG8_BAR;
        PG8_STAGE(PG8_SB(1, 0), cB + kstep, voffB); PG8_STAGE(PG8_SA(1, 0), cA + kstep, voffA); PG8_STAGE(PG8_SB(1, 1), cB + hstep + kstep, voffB);
        PG8_WAIT_V(6); PG8_BAR;
    }
    for (;;) {
        const bool has_next = S.next(ui + 1, nxt);
        const char* nA = has_next ? (const char*)g.A + (size_t)nxt.pm * tstep : cA; const char* nB = has_next ? (const char*)g.Bt + (size_t)nxt.pn * tstep : cB;
        for (int t = 0; t < nt; t += 2) {
            const bool last = (t == nt - 2);
            const char* a1 = cA + (size_t)(t + 1) * kstep;
            const char* a2 = last ? nA : cA + (size_t)(t + 2) * kstep; const char* b2 = last ? nB : cB + (size_t)(t + 2) * kstep;
            const char* a3 = a2 + kstep; const char* b3 = b2 + kstep;
            if (last && has_next) S.a_ready(nxt);
            if constexpr (SP2) {
            PG8_LDB(B0, 0, 0); PG8_LDB(B1, 0, 1); PG8_SCHED; PG8_LDA(At, 0, 0); PG8_STAGE(PG8_SA(1, 1), a1 + hstep, voffA);
            PG8_WAIT_V(8); PG8_WAIT_L(0); PG8_BAR; PG8_MMA(0, 0, At, B0); PG8_MMA(0, 1, At, B1); PG8_BAR; PG8_SCHED;
            PG8_LDA(At, 0, 1); PG8_STAGE(PG8_SB(0, 0), b2, voffB); PG8_STAGE(PG8_SB(0, 1), b2 + hstep, voffB); PG8_STAGE(PG8_SA(0, 0), a2, voffA);
            PG8_WAIT_V(8); PG8_WAIT_L(0); PG8_BAR; PG8_MMA(1, 0, At, B0); PG8_MMA(1, 1, At, B1); PG8_BAR; PG8_SCHED;
            PG8_LDB(B0, 1, 0); PG8_LDB(B1, 1, 1); PG8_SCHED; PG8_LDA(At, 1, 0); PG8_STAGE(PG8_SA(0, 1), a2 + hstep, voffA);
            PG8_WAIT_V(8); PG8_WAIT_L(0); PG8_BAR; PG8_MMA(0, 0, At, B0); PG8_MMA(0, 1, At, B1); PG8_BAR; PG8_SCHED;
            PG8_LDA(At, 1, 1); PG8_STAGE(PG8_SB(1, 0), b3, voffB); PG8_STAGE(PG8_SB(1, 1), b3 + hstep, voffB); PG8_STAGE(PG8_SA(1, 0), a3, voffA);
            PG8_WAIT_V(8); PG8_WAIT_L(0); PG8_BAR; PG8_MMA(1, 0, At, B0); PG8_MMA(1, 1, At, B1); PG8_BAR; PG8_SCHED;
            } else {
            PG8_LDB(B0, 0, 0); PG8_SCHED; PG8_LDA(At, 0, 0); PG8_STAGE(PG8_SA(1, 1), a1 + hstep, voffA);
            PG8_WAIT_L(8); PG8_BAR; PG8_WAIT_L(0); PG8_MMA(0, 0, At, B0); PG8_BAR; PG8_SCHED;
            PG8_LDB(B1, 0, 1); PG8_STAGE(PG8_SB(0, 0), b2, voffB);
            PG8_BAR; PG8_WAIT_L(0); PG8_MMA(0, 1, At, B1); PG8_BAR;
            PG8_LDA(At, 0, 1); PG8_STAGE(PG8_SA(0, 0), a2, voffA);
            PG8_BAR; PG8_WAIT_L(0); PG8_MMA(1, 0, At, B0); PG8_BAR; PG8_SCHED;
            PG8_STAGE(PG8_SB(0, 1), b2 + hstep, voffB);
            PG8_WAIT_V(6); PG8_BAR; PG8_MMA(1, 1, At, B1); PG8_BAR;
            PG8_LDB(B0, 1, 0); PG8_SCHED; PG8_LDA(At, 1, 0); PG8_STAGE(PG8_SA(0, 1), a2 + hstep, voffA);
            PG8_WAIT_L(8); PG8_BAR; PG8_WAIT_L(0); PG8_MMA(0, 0, At, B0); PG8_BAR; PG8_SCHED;
            PG8_LDB(B1, 1, 1); PG8_STAGE(PG8_SB(1, 0), b3, voffB);
            PG8_BAR; PG8_WAIT_L(0); PG8_MMA(0, 1, At, B1); PG8_BAR;
            PG8_LDA(At, 1, 1); PG8_STAGE(PG8_SA(1, 0), a3, voffA);
            PG8_BAR; PG8_WAIT_L(0); PG8_MMA(1, 0, At, B0); PG8_BAR; PG8_SCHED;
            PG8_STAGE(PG8_SB(1, 1), b3 + hstep, voffB);
            PG8_WAIT_V(6); PG8_BAR; PG8_MMA(1, 1, At, B1); PG8_BAR;
            }
        }
        if constexpr (ALIGN_EPI) { if (wr == 0) PG8_BAR; }
        if constexpr (!Epi::AFTER_DRAIN) { E(acc, cur, wr, wc, fr, fq); S.done(cur); }
        if (!has_next) break;
#pragma unroll
        for (int a = 0; a < 2; ++a)
#pragma unroll
            for (int b = 0; b < 2; ++b)
#pragma unroll
                for (int m = 0; m < 4; ++m)
#pragma unroll
                    for (int n = 0; n < 2; ++n) { float zr_ = 0.f; asm volatile("" : "+v"(zr_)); acc[a][b][m][n] = (f32x4){zr_, zr_, zr_, zr_}; }
        cur = nxt; cA = nA; cB = nB; ++ui;
        if constexpr (ALIGN_EPI) { if (wr == 1) PG8_BAR; }
    }
    PG8_WAIT_V(0);
    if constexpr (!ALIGN_EPI) { if (wr == 0) PG8_BAR; }
    PG8_BAR;
    if constexpr (Epi::AFTER_DRAIN) { E.fused(acc, cur, wr, wc, fr, fq, lds, wid, lane); S.done(cur); }
#undef PG8_SA
#undef PG8_SB
#undef PG8_STAGE
#undef PG8_LDA
#undef PG8_LDB
#undef PG8_MMA
#undef PG8_WAIT_V
#undef PG8_WAIT_L
#undef PG8_BAR
#undef PG8_SCHED
}
}

struct EpiStore {
    static constexpr bool PERM = true, AFTER_DRAIN = false;
    bf16_t* O; int ldc; int sig_pn;
    __device__ __forceinline__ void operator()(const f32x4 (&acc)[2][2][4][2], const pg8::Unit& u, int wr, int wc, int fr, int fq) const {
        const int row0 = u.pm * 256 + wr * 64 + fr, col0 = u.pn * 256 + wc * 32 + 8 * fq; const bool sg = u.pn >= sig_pn;
#pragma unroll
        for (int ai = 0; ai < 2; ++ai)
#pragma unroll
            for (int m = 0; m < 4; ++m) { bf16_t* rowp = O + (size_t)(row0 + ai * 128 + m * 16) * ldc + col0;
#pragma unroll
                for (int bj = 0; bj < 2; ++bj) { f32x4 v0 = acc[ai][bj][m][0], v1 = acc[ai][bj][m][1];
                    if (sg) {
#pragma unroll
                        for (int e = 0; e < 4; ++e) { v0[e] = __builtin_amdgcn_rcpf(1.f + __expf(-v0[e])); v1[e] = __builtin_amdgcn_rcpf(1.f + __expf(-v1[e])); } }
                    u32x4 w; w.x = pk2(v0[0], v0[1]); w.y = pk2(v0[2], v0[3]); w.z = pk2(v1[0], v1[1]); w.w = pk2(v1[2], v1[3]);
                    *(u32x4*)(rowp + bj * 128) = w; } }
    }
};
struct EpiMerge {
    static constexpr bool PERM = true, AFTER_DRAIN = false;
    bf16_t* Mg; const bf16_t* Pg;
    __device__ __forceinline__ void operator()(const f32x4 (&acc)[2][2][4][2], const pg8::Unit& u, int wr, int wc, int fr, int fq) const {
        const int br = u.pn >> 3, pn = u.pn & 7, pm = u.pm - br * 65;
        const int row0 = pm * 256 + wr * 64 + fr, col0 = pn * 256 + wc * 32 + 8 * fq;
#pragma unroll
        for (int ai = 0; ai < 2; ++ai) { u32x4 gw[4][2], ow[4][2];
#pragma unroll
            for (int m = 0; m < 4; ++m)
#pragma unroll
                for (int bj = 0; bj < 2; ++bj) { const int row = row0 + ai * 128 + m * 16, col = col0 + bj * 128;
                    gw[m][bj] = __builtin_nontemporal_load((const u32x4*)(Pg + (size_t)row * LDP + br * 2048 + col));
                    if (br) ow[m][bj] = *(const u32x4*)(Mg + (size_t)row * DM + col); else ow[m][bj] = (u32x4){0u, 0u, 0u, 0u}; }
#pragma unroll
            for (int m = 0; m < 4; ++m)
#pragma unroll
                for (int bj = 0; bj < 2; ++bj) { const int row = row0 + ai * 128 + m * 16, col = col0 + bj * 128;
                    const f32x4 v0 = acc[ai][bj][m][0], v1 = acc[ai][bj][m][1]; float r[8];
#pragma unroll
                    for (int e = 0; e < 4; ++e) { const float a0 = e < 2 ? v0[2 * e] : v1[2 * e - 4], a1 = e < 2 ? v0[2 * e + 1] : v1[2 * e - 3];
                        r[2 * e] = __uint_as_float(ow[m][bj][e] << 16) + __uint_as_float(gw[m][bj][e] << 16) * a0;
                        r[2 * e + 1] = __uint_as_float(ow[m][bj][e] & 0xffff0000u) + __uint_as_float(gw[m][bj][e] & 0xffff0000u) * a1; }
                    u32x4 w; w.x = pk2(r[0], r[1]); w.y = pk2(r[2], r[3]); w.z = pk2(r[4], r[5]); w.w = pk2(r[6], r[7]);
                    *(u32x4*)(Mg + (size_t)row * DM + col) = w; } }
    }
};
__device__ __forceinline__ float dpp_up(float cur, float prevreg) {
    const int o = __builtin_amdgcn_update_dpp(0, __float_as_int(prevreg), 0x121  , 0xf, 0xf, false);
    return __int_as_float(__builtin_amdgcn_update_dpp(o, __float_as_int(cur), 0x111  , 0xf, 0xf, false)); }
__device__ __forceinline__ float dpp_dn(float cur, float nextreg) {
    const int o = __builtin_amdgcn_update_dpp(0, __float_as_int(nextreg), 0x12F  , 0xf, 0xf, false);
    return __int_as_float(__builtin_amdgcn_update_dpp(o, __float_as_int(cur), 0x101  , 0xf, 0xf, false)); }
struct EpiHid {
    static constexpr bool PERM = true, AFTER_DRAIN = false;
    bf16_t* H; bf16_t* RAW; const float* cw; const float* cb;
    __device__ __forceinline__ void operator()(const f32x4 (&acc)[2][2][4][2], const pg8::Unit& u, int wr, int wc, int fr, int fq) const {
        const int rowb = u.pm * 256 + wr * 64, j0 = u.pn * 128 + wc * 32 + 8 * fq;
#pragma unroll
        for (int n = 0; n < 2; ++n) { const int j = j0 + 4 * n;
            f32x4 wa[3], wg[3]; const f32x4 ba = *(const f32x4*)(cb + j), bg = *(const f32x4*)(cb + DFF + j);
#pragma unroll
            for (int t = 0; t < 3; ++t) { wa[t] = *(const f32x4*)(cw + t * NUP + j); wg[t] = *(const f32x4*)(cw + t * NUP + DFF + j); }
#pragma unroll
            for (int ai = 0; ai < 2; ++ai)
#pragma unroll
                for (int m = 0; m < 4; ++m) { const f32x4 ac = acc[ai][0][m][n], gc = acc[ai][1][m][n];
                    const f32x4 ap = acc[ai][0][m > 0 ? m - 1 : m][n], gp = acc[ai][1][m > 0 ? m - 1 : m][n], an = acc[ai][0][m < 3 ? m + 1 : m][n], gn = acc[ai][1][m < 3 ? m + 1 : m][n];
                    float hv[4];
#pragma unroll
                    for (int e = 0; e < 4; ++e) { const float a = ba[e] + wa[0][e] * dpp_up(ac[e], ap[e]) + wa[1][e] * ac[e] + wa[2][e] * dpp_dn(ac[e], an[e]);
                        const float g = bg[e] + wg[0][e] * dpp_up(gc[e], gp[e]) + wg[1][e] * gc[e] + wg[2][e] * dpp_dn(gc[e], gn[e]);
                        hv[e] = g * __builtin_amdgcn_rcpf(1.f + __expf(-g)) * a; }
                    const int lrow = m * 16 + fr; const int row = rowb + ai * 128 + lrow;
                    if (lrow != 0 && lrow != 63) { u32x2 o; o.x = pk2(hv[0], hv[1]); o.y = pk2(hv[2], hv[3]); *(u32x2*)(H + (size_t)row * DFF + j) = o; }
                    if (lrow <= 1 || lrow >= 62) { const int slot = lrow <= 1 ? lrow : lrow - 60; bf16_t* rp = RAW + ((size_t)(row >> 6) * 4 + slot) * NUP + j;
                        u32x2 ra, rg; ra.x = pk2(ac[0], ac[1]); ra.y = pk2(ac[2], ac[3]); rg.x = pk2(gc[0], gc[1]); rg.y = pk2(gc[2], gc[3]);
                        *(u32x2*)rp = ra; *(u32x2*)(rp + DFF) = rg; } } }
    }
};
struct EpiResid {
    static constexpr bool PERM = false, AFTER_DRAIN = false;
    const float* hin; float* hout; const float* cin; float* cout; const float* gl; const float* gc;
    __device__ __forceinline__ void operator()(const f32x4 (&acc)[2][2][4][2], const pg8::Unit& u, int wr, int wc, int fr, int fq) const {
        const bool isc = u.pm == 64; const float* src = isc ? cin : hin; float* dst = isc ? cout : hout; const float* gv = isc ? gc : gl;
        const int rbase = (isc ? 0 : u.pm * 256) + wr * 64 + fr, col0 = u.pn * 256 + wc * 32 + 4 * fq;
#pragma unroll
        for (int bj = 0; bj < 2; ++bj)
#pragma unroll
            for (int n = 0; n < 2; ++n) { const int col = col0 + bj * 128 + n * 16; const f32x4 g = *(const f32x4*)(gv + col); f32x4 h[2][4];
#pragma unroll
                for (int ai = 0; ai < 2; ++ai)
#pragma unroll
                    for (int m = 0; m < 4; ++m) h[ai][m] = *(const f32x4*)(src + (size_t)(rbase + ai * 128 + m * 16) * DM + col);
#pragma unroll
                for (int ai = 0; ai < 2; ++ai)
#pragma unroll
                    for (int m = 0; m < 4; ++m) *(f32x4*)(dst + (size_t)(rbase + ai * 128 + m * 16) * DM + col) = h[ai][m] + g * acc[ai][bj][m][n]; }
    }
};
struct MergeOrder {
    int nM, G, c, ntile;
    __device__ void init(int M, int G_, int c_) { nM = M / 256; G = G_; c = c_; ntile = nM * 8; }
    __device__ bool next(int i, pg8::Unit& u) const { const int t = (i >> 2) * G + c; if (t >= ntile) return false; const int br = i & 3; u.pm = br * 65 + (t >> 3); u.pn = br * 8 + (t & 7); return true; }
    __device__ __forceinline__ void a_ready(const pg8::Unit&) const {}
    __device__ __forceinline__ void done(const pg8::Unit&) const {}
};

namespace att {
constexpr int D = 128, NW = 8, QBLK = 32, KVBLK = 64;
constexpr float SCALE = 0.088388347648318440f;
constexpr float THR = 8.f;
constexpr size_t SHM_V = KVBLK * D * 2, SHM_K = KVBLK * D * 2, SHM_ATTN = 2 * SHM_V + 2 * SHM_K + NW * 64 * 4;
#define KSWZ(row, colB) ((row) * 256 + ((colB) ^ (((row) & 7) << 4)))
#define SBAR() __builtin_amdgcn_sched_barrier(0)
__device__ __forceinline__ int crow(int r, int hi) { return (r & 3) + 8 * (r >> 2) + 4 * hi; }
struct NaInfo { int r0, rs0, nloc; const float* bias; };
template <int MODE>
__device__ __forceinline__ void na_mask(f32x16& p0, f32x16& p1, int t, int wid, int r32, int hi, const NaInfo& na) {
    if (MODE == 0) return;
    if (t < 4) return;
    const int qr = na.r0 + (wid >> 1), qc = (wid & 1) * 32 + r32;
    const int kr = na.rs0 + (t - 4);
    const int rs = min(max(qr - 4, 0), 248);
    const bool rowok = (t - 4 < na.nloc) && kr >= rs && kr < rs + 8;
    if (!rowok) {
#pragma unroll
        for (int r = 0; r < 16; ++r) { p0[r] = -1e30f; p1[r] = -1e30f; }
    } else {
        const int cs = min(max(qc - 8, 0), 48);
        const int bidx = (kr - qr + 7) * 31 + 15 - qc;
#pragma unroll
        for (int r = 0; r < 16; ++r) { const int k0 = crow(r, hi), k1 = 32 + k0;
            const bool ok0 = k0 >= cs && k0 < cs + 16, ok1 = k1 >= cs && k1 < cs + 16;
            const float b0 = na.bias[ok0 ? bidx + k0 : 0], b1 = na.bias[ok1 ? bidx + k1 : 0];
            p0[r] = ok0 ? p0[r] + b0 : -1e30f; p1[r] = ok1 ? p1[r] + b1 : -1e30f;
            if ((r & 3) == 3) asm volatile("" ::: "memory"); }
    }
}
__device__ __forceinline__ void partialSM(f32x16& p0, f32x16& p1, float& m_reg, float& mn, float& alpha) {
    constexpr float C = SCALE * 1.4426950408889634f;
    float pmax = p0[0];
#pragma unroll
    for (int r = 1; r < 16; ++r) pmax = fmaxf(pmax, p0[r]);
#pragma unroll
    for (int r = 0; r < 16; ++r) pmax = fmaxf(pmax, p1[r]);
    { auto rr = __builtin_amdgcn_permlane32_swap(__float_as_uint(pmax), __float_as_uint(pmax), false, false);
      pmax = fmaxf(__uint_as_float(rr[0]), __uint_as_float(rr[1])); }
    if (__builtin_expect(__all(pmax - m_reg <= THR / SCALE), 1)) { mn = m_reg; alpha = 1.f; }
    else { mn = fmaxf(m_reg, pmax); alpha = __builtin_amdgcn_exp2f((m_reg - mn) * C); m_reg = mn; }
    float mnC = -mn * C;
#pragma unroll
    for (int r = 0; r < 16; ++r) p0[r] = fmaf(p0[r], C, mnC);
#pragma unroll
    for (int r = 0; r < 16; ++r) p1[r] = fmaf(p1[r], C, mnC);
#pragma unroll
    for (int r = 0; r < 16; ++r) p0[r] = __builtin_amdgcn_exp2f(p0[r]);
}
__device__ __forceinline__ void finishSM(f32x16& p0, f32x16& p1, float alpha, float& l_reg, bf16x8& pa0, bf16x8& pa1, bf16x8& pa2, bf16x8& pa3) {
#pragma unroll
    for (int r = 0; r < 16; ++r) p1[r] = __builtin_amdgcn_exp2f(p1[r]);
    float ps = 0;
#pragma unroll
    for (int r = 0; r < 16; ++r) ps += p0[r];
#pragma unroll
    for (int r = 0; r < 16; ++r) ps += p1[r];
    { auto rr = __builtin_amdgcn_permlane32_swap(__float_as_uint(ps), __float_as_uint(ps), false, false);
      ps = __uint_as_float(rr[0]) + __uint_as_float(rr[1]); }
    l_reg = l_reg * alpha + ps;
#define PK4(P, BASE, OUT) do { unsigned a0 = pk2(P[BASE + 0], P[BASE + 1]), a1 = pk2(P[BASE + 2], P[BASE + 3]);   \
    unsigned b0 = pk2(P[BASE + 4], P[BASE + 5]), b1 = pk2(P[BASE + 6], P[BASE + 7]);                              \
    auto r0 = __builtin_amdgcn_permlane32_swap(a0, b0, false, false); auto r1 = __builtin_amdgcn_permlane32_swap(a1, b1, false, false); \
    u32x4 w = {r0[0], r1[0], r0[1], r1[1]}; OUT = *reinterpret_cast<bf16x8*>(&w); } while (0)
    PK4(p0, 0, pa0); PK4(p0, 8, pa1); PK4(p1, 0, pa2); PK4(p1, 8, pa3);
#undef PK4
}
__device__ __forceinline__ void qkt(f32x16& p0, f32x16& p1, const bf16_t* Ks, const bf16x8* qr, int r32, int hi) {
    p0 = f32x16{}; p1 = f32x16{};
#pragma unroll
    for (int d0 = 0; d0 < 8; ++d0) { int cb = (d0 * 16 + hi * 8) * 2;
        bf16x8 b0 = *reinterpret_cast<const bf16x8*>((const char*)Ks + KSWZ(r32, cb));
        bf16x8 b1 = *reinterpret_cast<const bf16x8*>((const char*)Ks + KSWZ(32 + r32, cb));
        p0 = __builtin_amdgcn_mfma_f32_32x32x16_bf16(b0, qr[d0], p0, 0, 0, 0);
        p1 = __builtin_amdgcn_mfma_f32_32x32x16_bf16(b1, qr[d0], p1, 0, 0, 0); }
}
__device__ __forceinline__ int v_st(int k, int c) { const int kk = (k & ~0xC) | ((k & 4) << 1) | ((k & 8) >> 1); return ((kk >> 3) * 4 + (c >> 5)) * 512 + ((kk & 7) * 32 + (c & 31)) * 2; }
__device__ __forceinline__ int v_rd_base(int lane) { return ((lane & 3) << 3) | (((lane >> 2) & 3) << 6) | (((lane >> 4) & 1) << 5) | (((lane >> 5) & 1) << 8); }
constexpr int v_rd_off(int d0, int ks, int half) { return d0 * 512 + ks * 4096 + half * 2048; }
template <int OFF> __device__ __forceinline__ s16x4 tr_read(int vb) {
    s16x4 r; asm volatile("ds_read_b64_tr_b16 %0, %1 offset:%2" : "=&v"(r) : "v"(vb), "i"(OFF) : "memory"); return r;
}
template <int D0> __device__ __forceinline__ void pv_one(f32x16& od, int vb, bf16x8 pa0, bf16x8 pa1, bf16x8 pa2, bf16x8 pa3) {
    const s16x4 l0 = tr_read<v_rd_off(D0, 0, 0)>(vb), h0 = tr_read<v_rd_off(D0, 0, 1)>(vb), l1 = tr_read<v_rd_off(D0, 1, 0)>(vb), h1 = tr_read<v_rd_off(D0, 1, 1)>(vb);
    const s16x4 l2 = tr_read<v_rd_off(D0, 2, 0)>(vb), h2 = tr_read<v_rd_off(D0, 2, 1)>(vb), l3 = tr_read<v_rd_off(D0, 3, 0)>(vb), h3 = tr_read<v_rd_off(D0, 3, 1)>(vb);
    asm volatile("s_waitcnt lgkmcnt(0)" ::: "memory"); SBAR();
#define PK(L, H) (bf16x8){L[0], L[1], L[2], L[3], H[0], H[1], H[2], H[3]}
    od = __builtin_amdgcn_mfma_f32_32x32x16_bf16(pa0, PK(l0, h0), od, 0, 0, 0);
    od = __builtin_amdgcn_mfma_f32_32x32x16_bf16(pa1, PK(l1, h1), od, 0, 0, 0);
    od = __builtin_amdgcn_mfma_f32_32x32x16_bf16(pa2, PK(l2, h2), od, 0, 0, 0);
    od = __builtin_amdgcn_mfma_f32_32x32x16_bf16(pa3, PK(l3, h3), od, 0, 0, 0);
#undef PK
}
__device__ __forceinline__ void pv_d0(f32x16* o, int vb, bf16x8 pa0, bf16x8 pa1, bf16x8 pa2, bf16x8 pa3) {
    pv_one<0>(o[0], vb, pa0, pa1, pa2, pa3); pv_one<1>(o[1], vb, pa0, pa1, pa2, pa3); pv_one<2>(o[2], vb, pa0, pa1, pa2, pa3); pv_one<3>(o[3], vb, pa0, pa1, pa2, pa3);
}
template <int MODE, int SD>
__device__ __forceinline__ void attn_body(const bf16_t* __restrict__ Qb, const bf16_t* __restrict__ Kh, const bf16_t* __restrict__ Vh,
                                          bf16_t* __restrict__ Ob, int NT, char* lds, const NaInfo na) {
    constexpr int ldq = LDP, ldk = LDP, ldv = LDP, ldo = 512;
    const int tid = ltid(), wid = tid >> 6, lane = tid & 63, r32 = lane & 31, hi = lane >> 5;
    bf16_t* V_lds = (bf16_t*)lds; bf16_t* K_lds = (bf16_t*)(lds + 2 * SHM_V);
    float* ws = (float*)(lds + 2 * SHM_V + 2 * SHM_K) + wid * 64; float* li_l = ws; float* al_l = ws + 32;
    float m_reg = -1e30f, l_reg = 0; f32x16 o[4] = {}; bf16x8 qr[8];
    const bf16_t* Qw = Qb + (long)(wid * QBLK + r32) * ldq + hi * 8;
#pragma unroll
    for (int d0 = 0; d0 < 8; ++d0) qr[d0] = *reinterpret_cast<const bf16x8*>(Qw + d0 * 16);
    const int sr = tid >> 4, sc = (tid & 15) * 8, vst0 = v_st(sr, sc), vst1 = v_st(32 + sr, sc);
    const int vb0 = (int)(uintptr_t)V_lds + v_rd_base(lane);
    struct { bf16x8 vs0, vs1, ks0, ks1; } sr_[SD];
#define K0OF(t) (MODE == 0 ? (t) * 64 : ((t) < 4 ? SEQ + 64 * (t) : (na.rs0 + min((t) - 4, na.nloc - 1)) * 64))
#define SLOAD(i, t) do { const int k0_ = K0OF(t); sr_[i].vs0 = *(const bf16x8*)(&Vh[(long)(k0_ + sr) * ldv + sc]); sr_[i].vs1 = *(const bf16x8*)(&Vh[(long)(k0_ + 32 + sr) * ldv + sc]); \
    sr_[i].ks0 = *(const bf16x8*)(&Kh[(long)(k0_ + sr) * ldk + sc]); sr_[i].ks1 = *(const bf16x8*)(&Kh[(long)(k0_ + 32 + sr) * ldk + sc]); } while (0)
#define SWRITE(b, i) do { *(bf16x8*)((char*)V_lds + (b) * SHM_V + vst0) = sr_[i].vs0;          \
    *(bf16x8*)((char*)V_lds + (b) * SHM_V + vst1) = sr_[i].vs1; int kc = sc * 2;               \
    *(bf16x8*)((char*)K_lds + (b) * SHM_K + KSWZ(sr, kc)) = sr_[i].ks0;                       \
    *(bf16x8*)((char*)K_lds + (b) * SHM_K + KSWZ(32 + sr, kc)) = sr_[i].ks1; } while (0)
#define SWAIT() do { if (SD == 2) asm volatile("s_waitcnt vmcnt(4)" ::: "memory"); else asm volatile("s_waitcnt vmcnt(0)" ::: "memory"); } while (0)
#define RESC(a) do { if (__any((a) < 1.f)) { if (hi == 0) al_l[r32] = (a); asm volatile("s_waitcnt lgkmcnt(0)" ::: "memory"); \
    _Pragma("unroll") for (int d = 0; d < 4; ++d) _Pragma("unroll") for (int r = 0; r < 16; ++r) o[d][r] *= al_l[crow(r, hi)]; } } while (0)
    f32x16 pA0, pA1, pB0, pB1; float mnA, mnB, alA, alB; bf16x8 pa0, pa1, pa2, pa3;
    constexpr int SE = 0, SO = SD - 1;
    SLOAD(SE, 0); asm volatile("s_waitcnt vmcnt(0)" ::: "memory"); SWRITE(0, SE); __syncthreads();
    qkt(pA0, pA1, K_lds, qr, r32, hi); na_mask<MODE>(pA0, pA1, 0, wid, r32, hi, na); partialSM(pA0, pA1, m_reg, mnA, alA);
    SLOAD(SO, 1); if (SD == 2) { if (2 < NT) SLOAD(SE, 2); }
    SWAIT(); SWRITE(1, SO); __syncthreads();
    for (int j = 1; j + 1 < NT; j += 2) {
        SBAR(); qkt(pB0, pB1, (bf16_t*)((char*)K_lds + SHM_K), qr, r32, hi); na_mask<MODE>(pB0, pB1, j, wid, r32, hi, na);
        finishSM(pA0, pA1, alA, l_reg, pa0, pa1, pa2, pa3); SBAR();
        SLOAD(SO, j + SD); SBAR();
        pv_d0(o, vb0, pa0, pa1, pa2, pa3); partialSM(pB0, pB1, m_reg, mnB, alB);
        __syncthreads(); SWAIT(); SWRITE(0, SE);
        RESC(alB); __syncthreads();
        SBAR(); qkt(pA0, pA1, K_lds, qr, r32, hi); na_mask<MODE>(pA0, pA1, j + 1, wid, r32, hi, na);
        finishSM(pB0, pB1, alB, l_reg, pa0, pa1, pa2, pa3); SBAR();
        if (SD == 1 || j + 3 < NT) SLOAD(SE, j + 1 + SD); SBAR();
        pv_d0(o, vb0 + (int)SHM_V, pa0, pa1, pa2, pa3); partialSM(pA0, pA1, m_reg, mnA, alA);
        __syncthreads(); SWAIT(); SWRITE(1, SO);
        RESC(alA); __syncthreads();
    }
    SBAR(); qkt(pB0, pB1, (bf16_t*)((char*)K_lds + SHM_K), qr, r32, hi); na_mask<MODE>(pB0, pB1, NT - 1, wid, r32, hi, na);
    finishSM(pA0, pA1, alA, l_reg, pa0, pa1, pa2, pa3); SBAR();
    pv_d0(o, vb0, pa0, pa1, pa2, pa3); partialSM(pB0, pB1, m_reg, mnB, alB);
    __syncthreads(); RESC(alB);
    finishSM(pB0, pB1, alB, l_reg, pa0, pa1, pa2, pa3); SBAR();
    pv_d0(o, vb0 + (int)SHM_V, pa0, pa1, pa2, pa3);
    if (hi == 0) li_l[r32] = l_reg; asm volatile("s_waitcnt lgkmcnt(0)" ::: "memory");
    float rli[16];
#pragma unroll
    for (int r = 0; r < 16; ++r) rli[r] = __builtin_amdgcn_rcpf(li_l[crow(r, hi)]);
    bf16_t* Ow = Ob + (long)(wid * QBLK) * ldo;
#pragma unroll
    for (int r = 0; r < 16; ++r) { int orow = crow(r, hi);
#pragma unroll
        for (int d0 = 0; d0 < 4; ++d0) Ow[(long)orow * ldo + d0 * 32 + r32] = f2bf(o[d0][r] * rli[r]); }
    __syncthreads();
#undef SLOAD
#undef SWRITE
#undef SWAIT
#undef RESC
#undef K0OF
}
}
#define XB_TMO      128
#define XB_XCNT(j)  (256  + 64 * (j))
#define XB_XSUB(j)  (1280 + 64 * (j))
#define XB_XGEN(j)  (2304 + 64 * (j))
#define XB_TOP      3328
#define XB_TOPGEN   3392
#define XCD_BAR_WORDS 3456
#define XB_SPIN_CAP (1u << 18)

__device__ __forceinline__ unsigned xb_ld(unsigned* p)              { return __hip_atomic_load(p, __ATOMIC_RELAXED, __HIP_MEMORY_SCOPE_AGENT); }
__device__ __forceinline__ unsigned xb_add(unsigned* p, unsigned v) { return __hip_atomic_fetch_add(p, v, __ATOMIC_RELAXED, __HIP_MEMORY_SCOPE_AGENT); }
__device__ __forceinline__ unsigned xb_xcc_id() { return (unsigned)__builtin_amdgcn_s_getreg((3 << 11) | 20) & 0xFu; }
#define XB_SPIN(cond, bar) do { unsigned _sp = 0; while (cond) { __builtin_amdgcn_s_sleep(1); \
    if ((++_sp & 255u) == 0u) { if (xb_ld(&(bar)[XB_TMO])) break; if (_sp > XB_SPIN_CAP) { atomicAdd(&(bar)[XB_TMO], 1u); break; } } } } while (0)

struct XcdBarrier {
    unsigned* bar; unsigned x;
    volatile __attribute__((address_space(3))) unsigned* st;
};

__device__ __forceinline__ XcdBarrier xcd_barrier_post(unsigned* bar, volatile __attribute__((address_space(3))) unsigned* st) {
    XcdBarrier b; b.bar = bar; b.x = xb_xcc_id(); b.st = st;
    if (threadIdx.x == 0) (void)xb_add(&bar[XB_XCNT(b.x)], 1u);
    return b;
}
__device__ __forceinline__ void xcd_barrier_complete(unsigned* bar, unsigned x, unsigned& nloc, unsigned& nx) {
    const unsigned G = gridDim.x * gridDim.y * gridDim.z;
    unsigned sum, cnt, mine, sp = 0u;
    for (;;) {
        sum = 0u; cnt = 0u; mine = 0u;
#pragma unroll
        for (unsigned j = 0; j < 16; ++j) { const unsigned c = xb_ld(&bar[XB_XCNT(j)]); sum += c; cnt += (c > 0u) ? 1u : 0u; mine = (j == x) ? c : mine; }
        if (sum == G) break;
        __builtin_amdgcn_s_sleep(1);
        if ((++sp & 255u) == 0u) { if (xb_ld(&bar[XB_TMO])) break; if (sp > XB_SPIN_CAP) { atomicAdd(&bar[XB_TMO], 1u); break; } }
    }
    nloc = mine > 0u ? mine : 1u; nx = cnt > 0u ? cnt : 1u;
}

__device__ __forceinline__ void xcd_barrier(const XcdBarrier& b) {
    asm volatile("s_waitcnt vmcnt(0)" ::: "memory");
    __syncthreads();
    if (threadIdx.x == 0) {
        unsigned* bar = b.bar;
        __builtin_amdgcn_s_waitcnt(0);
        unsigned nloc = b.st[0], nx = b.st[1];
        if (nloc == 0u) { xcd_barrier_complete(bar, b.x, nloc, nx); b.st[0] = nloc; b.st[1] = nx; }
        const unsigned old = xb_add(&bar[XB_XSUB(b.x)], 1u);
        const unsigned gen = old / nloc;
        if (old + 1u == (gen + 1u) * nloc) {
            __builtin_amdgcn_fence(__ATOMIC_RELEASE, "agent");
            asm volatile("s_waitcnt vmcnt(0)" ::: "memory");
            const unsigned og = xb_add(&bar[XB_TOP], 1u);
            const unsigned tg = og / nx;
            if (og + 1u == (tg + 1u) * nx) xb_add(&bar[XB_TOPGEN], 1u);
            else XB_SPIN(xb_ld(&bar[XB_TOPGEN]) == tg, bar);
            __builtin_amdgcn_fence(__ATOMIC_ACQUIRE, "agent");
            xb_add(&bar[XB_XGEN(b.x)], 1u);
            asm volatile("s_waitcnt vmcnt(0)" ::: "memory");
        } else {
            XB_SPIN(xb_ld(&bar[XB_XGEN(b.x)]) == gen, bar);
            __builtin_amdgcn_fence(__ATOMIC_ACQUIRE, "agent");
            asm volatile("s_waitcnt vmcnt(0)" ::: "memory");
        }
    }
    __syncthreads();
}


#define WSP(T, off) ((T*)(p.ws + (off)))

__device__ __forceinline__ void transpose_item(const float* __restrict__ W, int K, int N, bf16_t* __restrict__ WT, int tile, float* scr, int gap_at, int gap, bool ag = false) {
    const int nblk = N / 32, kb = tile / nblk, nb = tile % nblk, k0 = kb * 64, n0 = nb * 32, tid = ltid();
    { const int kk = tid >> 3, n4 = (tid & 7) * 4; const f32x4 v = __builtin_nontemporal_load((const f32x4*)(W + (size_t)(k0 + kk) * N + n0 + n4));
      scr[kk * 33 + n4] = v[0]; scr[kk * 33 + n4 + 1] = v[1]; scr[kk * 33 + n4 + 2] = v[2]; scr[kk * 33 + n4 + 3] = v[3]; }
    __syncthreads();
    { const int n = tid >> 4, kc = (tid & 15) * 4; const int jj0 = n0 % DFF; const int nd = ag ? ((jj0 >> 7) * 256 + (n0 >= DFF ? 128 : 0) + (jj0 & 127) + n) : (n0 + n + ((n0 >= gap_at) ? gap : 0));
      u32x2 o; o.x = pk2(scr[kc * 33 + n], scr[(kc + 1) * 33 + n]); o.y = pk2(scr[(kc + 2) * 33 + n], scr[(kc + 3) * 33 + n]);
      *(u32x2*)(WT + (size_t)nd * K + k0 + kc) = o; }
    __syncthreads();
}
__device__ __forceinline__ void convert_weights(const Params& p, int layer, char* smem, int mode, int b0) {
    float* scr = (float*)smem;
    constexpr int T_IN = 32 * (INW / 32), T_BR = 8 * 64, T_OUT = 32 * 64, T_UP = 32 * (NUP / 32), T_DN = (DFF / 64) * 64;
    constexpr int TOT = T_IN + 4 * T_BR + T_OUT + T_UP + T_DN;
    const float* w_in = p.in[8] + (size_t)layer * DM * INW; const float* brw = p.in[26] + (size_t)layer * 4 * 512 * DM;
    const float* wout = p.in[27] + (size_t)layer * DM * DM; const float* wup = p.in[28] + (size_t)layer * DM * NUP; const float* wdn = p.in[31] + (size_t)layer * DFF * DM;
    const int nb = (int)gridDim.x - b0, mb = (int)blockIdx.x - b0;
    if (mb < 0) return;
    const int it_lo = mode == 2 ? TOT - T_DN : 0, it_hi = mode == 1 ? TOT - T_DN : TOT;
    for (int it = it_lo + mb; it < it_hi; it += nb) {
        int r = it;
        if (r < T_IN) { transpose_item(w_in, DM, INW, WSP(bf16_t, WS_WIN), r, scr, NMIX, NPM - NMIX); continue; } r -= T_IN;
        if (r < 4 * T_BR) { const int b = r / T_BR; transpose_item(brw + (size_t)b * 512 * DM, 512, DM, WSP(bf16_t, WS_WBR) + (size_t)b * DM * 512, r % T_BR, scr, 1 << 30, 0); continue; } r -= 4 * T_BR;
        if (r < T_OUT) { transpose_item(wout, DM, DM, WSP(bf16_t, WS_WOUT), r, scr, 1 << 30, 0); continue; } r -= T_OUT;
        if (r < T_UP) { transpose_item(wup, DM, NUP, WSP(bf16_t, WS_WUP), r, scr, 1 << 30, 0, true); continue; } r -= T_UP;
        transpose_item(wdn, DFF, DM, WSP(bf16_t, WS_WDN), r, scr, 1 << 30, 0);
    }
    if (mode == 2) return;
    u32x4* z = (u32x4*)(WSP(bf16_t, WS_WIN) + (size_t)NMIX * DM); const int nz = (NPM - NMIX) * DM * 2 / 16;
    unsigned z0 = 0u; asm volatile("" : "+v"(z0));
    for (int i = mb * NTH + ltid(); i < nz; i += nb * NTH) z[i] = (u32x4){z0, z0, z0, z0};
}
__device__ __forceinline__ void mod_partials(const Params& p, char* smem) {
    float* sv = (float*)smem; const int tid = ltid();
    { const float* cl = p.in[1]; const float* cc = p.in[3]; for (int i = tid; i < 2048; i += NTH) { sv[i] = siluf_(cl[i]); sv[2048 + i] = siluf_(cc[i]); } }
    __syncthreads();
    for (int it = blockIdx.x; it < 2 * KS * 6; it += gridDim.x) {
        const int layer = it / (KS * 6), ks = (it / 6) % KS, cgp = it % 6, col = cgp * 2048 + tid * 4;
        const float* w = p.in[4] + (size_t)layer * DM * 12288 + col; f32x4 a0 = {0, 0, 0, 0}, a1 = {0, 0, 0, 0};
#pragma unroll 8
        for (int k = ks * 128; k < ks * 128 + 128; ++k) { const f32x4 wv = __builtin_nontemporal_load((const f32x4*)(w + (size_t)k * 12288)); a0 += wv * sv[k]; a1 += wv * sv[2048 + k]; }
        float* mp = WSP(float, WS_MODP) + (size_t)((ks * 2 + layer) * 2) * 12288 + col;
        *(f32x4*)mp = a0; *(f32x4*)(mp + 12288) = a1;
    }
    __syncthreads();
}
__device__ __forceinline__ void xn_phase(const Params& p, int layer, int which, char* smem) {
    float* sv = (float*)smem; const int tid = ltid(), wid = tid >> 6, lane = tid & 63;
    const float* modp = WSP(float, WS_MODP); float* mod = WSP(float, WS_MOD); const float* ada_b = p.in[5];
    for (int i = tid; i < 8192; i += NTH) { const int v = i >> 12, w = (i >> 11) & 1, col = i & 2047, off = (which ? 6144 : 0) + w * 2048 + col; float val;
        if (which == 0 && layer == 0) { val = ada_b[layer * 12288 + off]; for (int ks = 0; ks < KS; ++ks) val += modp[(size_t)((ks * 2 + layer) * 2 + v) * 12288 + off]; }
        else val = mod[(layer * 2 + v) * 12288 + off];
        sv[(v * 2 + w) * 2048 + col] = val; }
    if (which == 0 && layer == 0) { const int gid = lbid() * NTH + tid;
        if (gid < 4 * 12288) { const int lv = gid / 12288, off = gid % 12288; float val = ada_b[(lv >> 1) * 12288 + off];
            for (int ks = 0; ks < KS; ++ks) val += modp[(size_t)(ks * 4 + lv) * 12288 + off]; mod[gid] = val; } }
    __syncthreads();
    const bool first = (layer == 0 && which == 0);
    const float* x_in = p.in[0]; const float* c_in = p.in[2]; const float* o_in = p.out; const float* hc_in = WSP(float, WS_HC); const float* n1 = p.in[6]; const float* n2 = p.in[7];
    const float* lsrc = first ? x_in : o_in; const float* csrc = first ? c_in : hc_in;
    const float* g = (which ? n2 : n1) + layer * DM; bf16_t* XN = WSP(bf16_t, WS_XN);
    const int nrows = (which == 1 && layer == 1) ? SEQ : MALL;
    for (int row = blockIdx.x * 8 + wid; row < nrows; row += gridDim.x * 8) {
        const bool isc = row >= SEQ; const float* src = isc ? csrc + (size_t)(row - SEQ) * DM : lsrc + (size_t)row * DM;
        const float* sh = sv + (isc ? 4096 : 0); const float* sc = sh + 2048;
        f32x4 v[8]; float ss = 0.f;
#pragma unroll
        for (int j = 0; j < 8; ++j) { v[j] = *(const f32x4*)(src + 4 * (lane + 64 * j)); ss += (v[j][0] * v[j][0] + v[j][1] * v[j][1]) + (v[j][2] * v[j][2] + v[j][3] * v[j][3]); }
        const float rinv = rsqrtf(wave_sum(ss) * (1.f / DM) + 1e-6f);
#pragma unroll
        for (int j = 0; j < 8; ++j) { const int c = 4 * (lane + 64 * j); const f32x4 gg = *(const f32x4*)(g + c); float y[4];
#pragma unroll
            for (int e = 0; e < 4; ++e) y[e] = v[j][e] * rinv * gg[e] * (1.f + sc[c + e]) + sh[c + e];
            u32x2 o; o.x = pk2(y[0], y[1]); o.y = pk2(y[2], y[3]); *(u32x2*)(XN + (size_t)row * DM + c) = o; }
    }
    __syncthreads();
}
__device__ __forceinline__ void final_norm(const Params& p) {
    const int wid = ltid() >> 6, lane = ltid() & 63; const float* g = p.in[32];
    for (int row = blockIdx.x * 8 + wid; row < SEQ; row += gridDim.x * 8) { float* src = p.out + (size_t)row * DM; f32x4 v[8]; float ss = 0.f;
#pragma unroll
        for (int j = 0; j < 8; ++j) { v[j] = *(const f32x4*)(src + 4 * (lane + 64 * j)); ss += (v[j][0] * v[j][0] + v[j][1] * v[j][1]) + (v[j][2] * v[j][2] + v[j][3] * v[j][3]); }
        const float rinv = rsqrtf(wave_sum(ss) * (1.f / DM) + 1e-6f);
#pragma unroll
        for (int j = 0; j < 8; ++j) { const int c = 4 * (lane + 64 * j); const f32x4 gg = *(const f32x4*)(g + c); *(f32x4*)(src + c) = v[j] * rinv * gg; }
    }
}
__device__ __forceinline__ void hid_fix_phase(const Params& p, int layer, int nrows) {
    const bf16_t* RAW = WSP(bf16_t, WS_U); bf16_t* H = WSP(bf16_t, WS_HID);
    const float* cw = p.in[29] + (size_t)layer * 3 * NUP; const float* cb = p.in[30] + (size_t)layer * NUP;
    constexpr int NCG = DFF / 8; const int total = (nrows / 64) * 2 * NCG;
    for (int it = lbid() * NTH + ltid(); it < total; it += gridDim.x * NTH) {
        const int e = it / NCG, c8 = (it % NCG) * 8, blk = e >> 1, which = e & 1, row = 64 * blk + (which ? 63 : 0);
        const bool isc = row >= SEQ; const int lo = isc ? SEQ : 0, hi = isc ? MALL : SEQ;
        const bool okp = which || row > lo, okn = !which || row + 1 < hi;
        const bf16_t* rc = RAW + ((size_t)blk * 4 + (which ? 3 : 0)) * NUP + c8;
        const bf16_t* rp = which ? RAW + ((size_t)blk * 4 + 2) * NUP + c8 : (okp ? RAW + ((size_t)(blk - 1) * 4 + 3) * NUP + c8 : rc);
        const bf16_t* rn = which ? (okn ? RAW + ((size_t)(blk + 1) * 4 + 0) * NUP + c8 : rc) : RAW + ((size_t)blk * 4 + 1) * NUP + c8;
        u32x4 ua[3], ug[3]; unsigned z0 = 0u; const u32x4 zz = {z0, z0, z0, z0};
        ua[0] = *(const u32x4*)rp; ug[0] = *(const u32x4*)(rp + DFF); if (!okp) { ua[0] = zz; ug[0] = zz; }
        ua[1] = *(const u32x4*)rc; ug[1] = *(const u32x4*)(rc + DFF);
        ua[2] = *(const u32x4*)rn; ug[2] = *(const u32x4*)(rn + DFF); if (!okn) { ua[2] = zz; ug[2] = zz; }
        u32x4 o;
#pragma unroll
        for (int e2 = 0; e2 < 4; ++e2) { float a0 = cb[c8 + 2 * e2], a1 = cb[c8 + 2 * e2 + 1], g0 = cb[DFF + c8 + 2 * e2], g1 = cb[DFF + c8 + 2 * e2 + 1];
#pragma unroll
            for (int t = 0; t < 3; ++t) { const unsigned xa = ua[t][e2], xg = ug[t][e2];
                a0 += cw[t * NUP + c8 + 2 * e2] * __uint_as_float(xa << 16); a1 += cw[t * NUP + c8 + 2 * e2 + 1] * __uint_as_float(xa & 0xffff0000u);
                g0 += cw[t * NUP + DFF + c8 + 2 * e2] * __uint_as_float(xg << 16); g1 += cw[t * NUP + DFF + c8 + 2 * e2 + 1] * __uint_as_float(xg & 0xffff0000u); }
            o[e2] = pk2(siluf_(g0) * a0, siluf_(g1) * a1); }
        *(u32x4*)(H + (size_t)row * DFF + c8) = o;
    }
}

__device__ __forceinline__ void qk_item(const Params& p, int layer, int item) {
    const int tid = ltid(), wid = tid >> 6, lane = tid & 63, row = item * 8 + wid; bf16_t* P = WSP(bf16_t, WS_P);
    const int hv = lane >> 3, sub = lane & 7, axis = sub >> 2, f0 = 8 * (sub & 3);
    if (hv >= 6) return;
    const bool lat = row < SEQ; const int pos = axis ? (row & 63) : (row >> 6);
    bf16_t* ptr = P + (size_t)row * LDP + (hv < 4 ? C_AQ + hv * 128 : C_AK + (hv - 4) * 128) + axis * 64 + f0;
    const float* g = (hv < 4 ? p.in[9] : p.in[10]) + layer * 128 + axis * 64 + f0;
    const u32x4 w1 = *(const u32x4*)ptr, w2 = *(const u32x4*)(ptr + 32);
    float x1[8], x2[8], ss = 0.f;
#pragma unroll
    for (int e2 = 0; e2 < 4; ++e2) { x1[2 * e2] = __uint_as_float(w1[e2] << 16); x1[2 * e2 + 1] = __uint_as_float(w1[e2] & 0xffff0000u); x2[2 * e2] = __uint_as_float(w2[e2] << 16); x2[2 * e2 + 1] = __uint_as_float(w2[e2] & 0xffff0000u); }
#pragma unroll
    for (int j = 0; j < 8; ++j) ss += x1[j] * x1[j] + x2[j] * x2[j];
    ss += __shfl_xor(ss, 1); ss += __shfl_xor(ss, 2); ss += __shfl_xor(ss, 4);
    const float rinv = rsqrtf(ss * (1.f / 128.f) + 1e-6f);
    float o1[8], o2[8];
#pragma unroll
    for (int j = 0; j < 8; ++j) { float c = 1.f, s = 0.f;
        if (lat) { const float invf = exp2f(-(float)(f0 + j) * (13.287712379549449f / 32.f)); sincos_((float)pos * invf, s, c); }
        const float a = x1[j] * rinv * g[j], b = x2[j] * rinv * g[32 + j];
        o1[j] = a * c - b * s; o2[j] = b * c + a * s; }
    u32x4 r1, r2;
#pragma unroll
    for (int e2 = 0; e2 < 4; ++e2) { r1[e2] = pk2(o1[2 * e2], o1[2 * e2 + 1]); r2[e2] = pk2(o2[2 * e2], o2[2 * e2 + 1]); }
    *(u32x4*)ptr = r1; *(u32x4*)(ptr + 32) = r2;
}
#define TSW(r, c) ((r) * 72 + (c))
__device__ __forceinline__ int gla_base(int dir, int c) { if (c < 4) return SEQ + (dir ? (3 - c) : c) * 64; const int m = dir ? 255 - (c - 4) : c - 4; return m * 64; }
__device__ __forceinline__ float logsig_(float x) { return fminf(x, 0.f) - log1pf(__expf(-fabsf(x))); }
template <bool ROWORD>
__device__ __forceinline__ void gla_gates(const Params& p, int layer, int dir, int head, int base, float* bb, float* as_, float* w2s, float* gb) {
    const int tid = ltid(); const bf16_t* P = WSP(bf16_t, WS_P);
    for (int i = tid; i < 1024; i += NTH) { const int ii = i >> 4, r = i & 15; const int row = base + ((dir && !ROWORD) ? 63 - ii : ii);
        as_[i] = bf2f(P[(size_t)row * LDP + C_CA + dir * 16 + r]);
        const int rr = i >> 6, d = i & 63; w2s[i] = p.in[12][((size_t)(layer * 2 + dir) * 16 + rr) * 256 + head * 64 + d]; }
    if (tid < 64) gb[tid] = p.in[13][(layer * 2 + dir) * 256 + head * 64 + tid];
    __syncthreads();
    { const int d = tid & 63, i0 = tid >> 6; float wcol[16]; const float g0 = gb[d];
#pragma unroll
      for (int r = 0; r < 16; ++r) wcol[r] = w2s[r * 64 + d];
#pragma unroll
      for (int k = 0; k < 8; ++k) { const int ii = i0 + 8 * k; float x = g0;
#pragma unroll
          for (int r4 = 0; r4 < 4; ++r4) { const f32x4 av = *(const f32x4*)(as_ + ii * 16 + 4 * r4);
#pragma unroll
              for (int e = 0; e < 4; ++e) x += av[e] * wcol[4 * r4 + e]; }
          bb[ii * 64 + d] = logsig_(x) * (1.f / 16.f); } }
    __syncthreads();
    { const int d = tid & 63, seg = tid >> 6; const bool rev = ROWORD && dir; float v[8]; float run = 0.f;
#pragma unroll
      for (int k = 0; k < 8; ++k) { const int s = seg * 8 + k, ii = rev ? 63 - s : s; run += bb[ii * 64 + d]; v[k] = run; }
      as_[seg * 64 + d] = run;
      __syncthreads();
      float off = 0.f;
#pragma unroll
      for (int s2 = 0; s2 < 7; ++s2) off += (s2 < seg) ? as_[s2 * 64 + d] : 0.f;
#pragma unroll
      for (int k = 0; k < 8; ++k) { const int s = seg * 8 + k, ii = rev ? 63 - s : s; bb[ii * 64 + d] = v[k] + off; } }
    __syncthreads();
}
__device__ __forceinline__ void gla_local_item(const Params& p, int layer, int item, char* smem) {
    const int tid = ltid(), wid = __builtin_amdgcn_readfirstlane(tid >> 6), lane = tid & 63, r32 = lane & 31, hi = lane >> 5;
    const int dir = item / (4 * NCHUNK), head = (item / NCHUNK) & 3, c = item % NCHUNK, base = gla_base(dir, c);
    bf16_t* ktT = (bf16_t*)smem; bf16_t* vT = ktT + 64 * 72; float* bb = (float*)(vT + 128 * 72); float* as_ = bb + 4096; float* w2s = as_ + 1024; float* gb = w2s + 1024;
    const bf16_t* P = WSP(bf16_t, WS_P);
    gla_gates<false>(p, layer, dir, head, base, bb, as_, w2s, gb);
    { const int ii = tid >> 3, d0 = (tid & 7) * 8; const bf16_t* pr = P + (size_t)(base + (dir ? 63 - ii : ii)) * LDP;
      const u32x4 kw = *(const u32x4*)(pr + C_CK + head * 64 + d0);
#pragma unroll
      for (int e2 = 0; e2 < 4; ++e2) { const int d = d0 + 2 * e2;
          ktT[TSW(d, ii)] = f2bf(__uint_as_float(kw[e2] << 16) * __expf(bb[63 * 64 + d] - bb[ii * 64 + d]));
          ktT[TSW(d + 1, ii)] = f2bf(__uint_as_float(kw[e2] & 0xffff0000u) * __expf(bb[63 * 64 + d + 1] - bb[ii * 64 + d + 1])); }
      const int e0 = (tid & 7) * 16; const u32x4 va = *(const u32x4*)(pr + C_CV + head * 128 + e0), vb = *(const u32x4*)(pr + C_CV + head * 128 + e0 + 8);
#pragma unroll
      for (int e2 = 0; e2 < 4; ++e2) { vT[TSW(e0 + 2 * e2, ii)] = (bf16_t)(va[e2] & 0xffffu); vT[TSW(e0 + 2 * e2 + 1, ii)] = (bf16_t)(va[e2] >> 16);
          vT[TSW(e0 + 8 + 2 * e2, ii)] = (bf16_t)(vb[e2] & 0xffffu); vT[TSW(e0 + 9 + 2 * e2, ii)] = (bf16_t)(vb[e2] >> 16); } }
    __syncthreads();
    const int mi = wid >> 2, ne = wid & 3; f32x16 acc = {};
#pragma unroll
    for (int ks = 0; ks < 4; ++ks) { const bf16x8 A = *(const bf16x8*)(ktT + TSW(32 * mi + r32, 16 * ks + 8 * hi)), B = *(const bf16x8*)(vT + TSW(32 * ne + r32, 16 * ks + 8 * hi));
        acc = __builtin_amdgcn_mfma_f32_32x32x16_bf16(A, B, acc, 0, 0, 0); }
    const size_t sidx = (size_t)((dir * 4 + head) * NCHUNK + c);
    float* GS = WSP(float, WS_GS) + sidx * 8192;
#pragma unroll
    for (int r = 0; r < 16; ++r) GS[(32 * mi + att::crow(r, hi)) * 128 + 32 * ne + r32] = acc[r];
    if (tid < 64) WSP(float, WS_GD)[sidx * 64 + tid] = __expf(bb[63 * 64 + tid]);
    __syncthreads();
}
__device__ __forceinline__ void gla_scan_item(const Params& p, int layer, int item) {
    const int dh = item >> 4, elem = (item & 15) * NTH + ltid(), d = elem >> 7;
    float* GS = WSP(float, WS_GS) + (size_t)dh * NCHUNK * 8192 + elem; const float* GD = WSP(float, WS_GD) + (size_t)dh * NCHUNK * 64 + d;
    float S = 0.f;
    for (int c = 0; c < NCHUNK; c += 13) { float L[13], Dv[13];
#pragma unroll
        for (int u = 0; u < 13; ++u) { L[u] = GS[(size_t)(c + u) * 8192]; Dv[u] = GD[(c + u) * 64]; }
#pragma unroll
        for (int u = 0; u < 13; ++u) { GS[(size_t)(c + u) * 8192] = S; S = Dv[u] * S + L[u]; } }
    __threadfence(); __syncthreads();
    if (ltid() == 0) __hip_atomic_fetch_add(WSP(unsigned, WS_CTL) + 64 * layer, 1u, __ATOMIC_RELEASE, __HIP_MEMORY_SCOPE_AGENT);
}
__device__ __forceinline__ void gla_scan_wait(const Params& p, int layer) {
    if (ltid() == 0) { while (__hip_atomic_load(WSP(unsigned, WS_CTL) + 64 * layer, __ATOMIC_ACQUIRE, __HIP_MEMORY_SCOPE_AGENT) < 128u) __builtin_amdgcn_s_sleep(8); }
    __syncthreads(); __threadfence();
}
__device__ __forceinline__ void gla_out_item(const Params& p, int layer, int item, char* smem) {
    const int tid = ltid(), wid = __builtin_amdgcn_readfirstlane(tid >> 6), lane = tid & 63, r32 = lane & 31, hi = lane >> 5;
    const int head = item & 3, m = item >> 2, rbase = m < 256 ? m * 64 : SEQ + (m - 256) * 64;
    bf16_t* qtb = (bf16_t*)smem; bf16_t* ktb = qtb + 64 * 72; bf16_t* attb = ktb + 64 * 72; bf16_t* vT = attb + 64 * 72; bf16_t* ST = vT + 128 * 72;
    float* bb = (float*)(ST + 128 * 72); float* as_ = bb + 4096; float* w2s = as_ + 1024; float* gb = w2s + 1024; float* obuf = (float*)smem;
    const bf16_t* P = WSP(bf16_t, WS_P);
    const int omi = wid >> 2, one = wid & 3; f32x16 acc = {};
    const int ii = tid >> 3, d0 = (tid & 7) * 8, e0 = (tid & 7) * 16; const bf16_t* pr = P + (size_t)(rbase + ii) * LDP;
    const u32x4 qw = *(const u32x4*)(pr + C_CQ + head * 64 + d0), kw = *(const u32x4*)(pr + C_CK + head * 64 + d0);
    { const u32x4 va = *(const u32x4*)(pr + C_CV + head * 128 + e0), vb = *(const u32x4*)(pr + C_CV + head * 128 + e0 + 8);
#pragma unroll
      for (int e2 = 0; e2 < 4; ++e2) { vT[TSW(e0 + 2 * e2, ii)] = (bf16_t)(va[e2] & 0xffffu); vT[TSW(e0 + 2 * e2 + 1, ii)] = (bf16_t)(va[e2] >> 16);
          vT[TSW(e0 + 8 + 2 * e2, ii)] = (bf16_t)(vb[e2] & 0xffffu); vT[TSW(e0 + 9 + 2 * e2, ii)] = (bf16_t)(vb[e2] >> 16); } }
    for (int dir = 0; dir < 2; ++dir) {
        const int c = m < 256 ? (dir ? 4 + 255 - m : 4 + m) : (dir ? 3 - (m - 256) : (m - 256));
        gla_gates<true>(p, layer, dir, head, rbase, bb, as_, w2s, gb);
        { u32x4 qo, ko;
#pragma unroll
          for (int e2 = 0; e2 < 4; ++e2) { const float b0 = bb[ii * 64 + d0 + 2 * e2], b1 = bb[ii * 64 + d0 + 2 * e2 + 1];
              qo[e2] = pk2(__uint_as_float(qw[e2] << 16) * 0.125f * __expf(b0), __uint_as_float(qw[e2] & 0xffff0000u) * 0.125f * __expf(b1));
              ko[e2] = pk2(__uint_as_float(kw[e2] << 16) * __expf(-b0), __uint_as_float(kw[e2] & 0xffff0000u) * __expf(-b1)); }
          *(u32x4*)(qtb + ii * 72 + d0) = qo; *(u32x4*)(ktb + ii * 72 + d0) = ko;
          const float* GS = WSP(float, WS_GS) + (size_t)((dir * 4 + head) * NCHUNK + c) * 8192 + ii * 128 + e0;
#pragma unroll
          for (int e4 = 0; e4 < 4; ++e4) { const f32x4 sv = *(const f32x4*)(GS + 4 * e4);
#pragma unroll
              for (int x = 0; x < 4; ++x) ST[TSW(e0 + 4 * e4 + x, ii)] = f2bf(sv[x]); } }
        __syncthreads();
        if (wid < 4) { const int mi = wid >> 1, nj = wid & 1; f32x16 t = {};
            if (dir ? (nj >= mi) : (nj <= mi)) {
#pragma unroll
                for (int ks = 0; ks < 4; ++ks) { const bf16x8 A = *(const bf16x8*)(qtb + (32 * mi + r32) * 72 + 16 * ks + 8 * hi), B = *(const bf16x8*)(ktb + (32 * nj + r32) * 72 + 16 * ks + 8 * hi);
                    t = __builtin_amdgcn_mfma_f32_32x32x16_bf16(A, B, t, 0, 0, 0); } }
#pragma unroll
            for (int r = 0; r < 16; ++r) { const int i = 32 * mi + att::crow(r, hi), j = 32 * nj + r32; const bool keep = dir ? (j >= i) : (j <= i); attb[i * 72 + j] = keep ? f2bf(t[r]) : (bf16_t)0; } }
        __syncthreads();
#pragma unroll
        for (int ks = 0; ks < 4; ++ks) { const bf16x8 A = *(const bf16x8*)(qtb + (32 * omi + r32) * 72 + 16 * ks + 8 * hi), B = *(const bf16x8*)(ST + TSW(32 * one + r32, 16 * ks + 8 * hi));
            acc = __builtin_amdgcn_mfma_f32_32x32x16_bf16(A, B, acc, 0, 0, 0); }
#pragma unroll
        for (int ks = 0; ks < 4; ++ks) { const bf16x8 A = *(const bf16x8*)(attb + (32 * omi + r32) * 72 + 16 * ks + 8 * hi), B = *(const bf16x8*)(vT + TSW(32 * one + r32, 16 * ks + 8 * hi));
            acc = __builtin_amdgcn_mfma_f32_32x32x16_bf16(A, B, acc, 0, 0, 0); }
        __syncthreads();
    }
#pragma unroll
    for (int r = 0; r < 16; ++r) obuf[(32 * omi + att::crow(r, hi)) * 132 + 32 * one + r32] = acc[r];
    __syncthreads();
    const int g = tid >> 5, e4 = tid & 31;
    const float* ng = p.in[14] + layer * 128 + 4 * e4; const f32x4 ngv = *(const f32x4*)ng;
    bf16_t* Y = WSP(bf16_t, WS_YS) + (size_t)2 * MALL * 512;
#pragma unroll
    for (int x = 0; x < 4; ++x) { const f32x4 o = *(const f32x4*)(obuf + (4 * g + x) * 132 + 4 * e4); float ss = (o[0] * o[0] + o[1] * o[1]) + (o[2] * o[2] + o[3] * o[3]);
#pragma unroll
        for (int off = 1; off < 32; off <<= 1) ss += __shfl_xor(ss, off);
        const float rinv = rsqrtf(ss * (1.f / 128.f) + 1e-6f); const int row = rbase + 4 * g + x;
        const u32x2 gw = *(const u32x2*)(P + (size_t)row * LDP + C_CG + head * 128 + 4 * e4);
        const float g0 = __uint_as_float(gw.x << 16), g1 = __uint_as_float(gw.x & 0xffff0000u), g2 = __uint_as_float(gw.y << 16), g3 = __uint_as_float(gw.y & 0xffff0000u);
        u32x2 w; w.x = pk2(o[0] * rinv * ngv[0] * siluf_(g0), o[1] * rinv * ngv[1] * siluf_(g1)); w.y = pk2(o[2] * rinv * ngv[2] * siluf_(g2), o[3] * rinv * ngv[3] * siluf_(g3));
        *(u32x2*)(Y + (size_t)row * 512 + head * 128 + 4 * e4) = w; }
    __syncthreads();
}
__device__ __forceinline__ void hyena_z_item(const Params& p, int layer, int item, char* smem) {
    const int tid = ltid(), cgp = tid & 63, rg = tid >> 6, ch0 = 8 * cgp, p0 = item * 32, r0 = p0 + 4 * rg;
    const bool isc = p0 >= SEQ; const int lo = isc ? SEQ : 0, hi = isc ? MALL : SEQ;
    const bf16_t* P = WSP(bf16_t, WS_P) + C_DU + ch0; const float* cw = p.in[15] + (size_t)layer * 3 * 1536; const float* cb = p.in[16] + (size_t)layer * 1536;
    bf16_t* zt = (bf16_t*)smem; bf16_t* xt = zt + 512 * 40;
    float val[3][4][8];
#pragma unroll
    for (int gch = 0; gch < 3; ++gch) { float w[3][8], b[8];
#pragma unroll
        for (int h = 0; h < 2; ++h) { const f32x4 bv = *(const f32x4*)(cb + gch * 512 + ch0 + 4 * h);
#pragma unroll
            for (int x = 0; x < 4; ++x) b[4 * h + x] = bv[x];
#pragma unroll
            for (int k = 0; k < 3; ++k) { const f32x4 wv = *(const f32x4*)(cw + k * 1536 + gch * 512 + ch0 + 4 * h);
#pragma unroll
                for (int x = 0; x < 4; ++x) w[k][4 * h + x] = wv[x]; } }
        u32x4 u[6];
#pragma unroll
        for (int t = 0; t < 6; ++t) { const int r = r0 + t - 1; const bool ok = r >= lo && r < hi; u[t] = *(const u32x4*)(P + (size_t)(ok ? r : r0) * LDP + gch * 512); if (!ok) { unsigned z0 = 0u; u[t] = (u32x4){z0, z0, z0, z0}; } }
#pragma unroll
        for (int rr = 0; rr < 4; ++rr)
#pragma unroll
            for (int e2 = 0; e2 < 4; ++e2) { float a0 = b[2 * e2], a1 = b[2 * e2 + 1];
#pragma unroll
                for (int k = 0; k < 3; ++k) { const unsigned x = u[rr + k][e2]; a0 += w[k][2 * e2] * __uint_as_float(x << 16); a1 += w[k][2 * e2 + 1] * __uint_as_float(x & 0xffff0000u); }
                val[gch][rr][2 * e2] = a0; val[gch][rr][2 * e2 + 1] = a1; } }
#pragma unroll
    for (int c8 = 0; c8 < 8; ++c8) { u32x2 zo, xo;
        zo.x = pk2(val[2][0][c8] * val[1][0][c8], val[2][1][c8] * val[1][1][c8]); zo.y = pk2(val[2][2][c8] * val[1][2][c8], val[2][3][c8] * val[1][3][c8]);
        xo.x = pk2(val[0][0][c8], val[0][1][c8]); xo.y = pk2(val[0][2][c8], val[0][3][c8]);
        *(u32x2*)(zt + (ch0 + c8) * 40 + 4 * rg) = zo; *(u32x2*)(xt + (ch0 + c8) * 40 + 4 * rg) = xo; }
    __syncthreads();
    bf16_t* ZT = WSP(bf16_t, WS_ZT); bf16_t* X0T = WSP(bf16_t, WS_X0T);
#pragma unroll
    for (int k = 0; k < 4; ++k) { const int piece = tid + NTH * k, ch = piece >> 2, part = piece & 3;
        *(u32x4*)(ZT + (size_t)ch * MALL + p0 + 8 * part) = *(const u32x4*)(zt + ch * 40 + 8 * part);
        *(u32x4*)(X0T + (size_t)ch * MALL + p0 + 8 * part) = *(const u32x4*)(xt + ch * 40 + 8 * part); }
    __syncthreads();
}
constexpr int HF_W = 24576;
__device__ __forceinline__ void hyena_filter_prep(const Params& p, int layer, char* smem) {
    const int tid = ltid(); float* w = (float*)(smem + HF_W);
    const float* w1 = p.in[17] + (size_t)layer * 33 * 64; const float* w2 = p.in[19] + (size_t)layer * 4096; const float* w3 = p.in[21] + (size_t)layer * 4096;
    for (int i = tid; i < 2112; i += NTH) w[i] = w1[i];
    for (int i = tid; i < 4096; i += NTH) { w[2112 + i] = w2[i]; w[2112 + 4096 + i] = w3[i]; }
    if (tid < 64) { w[10304 + tid] = p.in[18][layer * 64 + tid]; w[10368 + tid] = p.in[20][layer * 64 + tid]; w[10432 + tid] = p.in[22][layer * 64 + tid]; w[10496 + tid] = p.in[24][layer * 64 + tid]; }
    __syncthreads();
}
__device__ __forceinline__ void hyena_filter_item(const Params& p, int layer, int item, char* smem) {
    const int tid = ltid(); const bool isc = item >= 512; const int L = isc ? CTXL : SEQ, p0 = (isc ? item - 512 : item) * 32;
    float* zf = (float*)smem; float* h1 = zf + 32 * 33; float* h2 = h1 + 32 * 64;
    const float* w1 = (const float*)(smem + HF_W); const float* w2 = w1 + 2112; const float* w3 = w2 + 4096; const float* b1 = w3 + 4096; const float* b2 = b1 + 64; const float* b3 = b2 + 64; const float* fr = b3 + 64;
    const float* w4 = p.in[23] + (size_t)layer * 64 * 1024;
    for (int i = tid; i < 32 * 33; i += NTH) { const int q = i / 33, k = i % 33; const int pos = p0 + q; const float tt = (float)pos / (float)(L - 1), w = 6.283185307179586f * (float)pos / (float)L; float val;
        if (k == 0) val = tt; else { const int b = (k - 1) & 15; const float fb = 1e-4f + (float)b * ((15.f - 1e-4f) / 15.f); val = k <= 16 ? cos_(fb * w) : -sin_(fb * w); }
        zf[k * 32 + q] = val; }
    __syncthreads();
    { const int j = tid & 63, qg = tid >> 6; const float fj = fr[j];
      { f32x4 a = {b1[j], b1[j], b1[j], b1[j]};
#pragma unroll 3
        for (int k = 0; k < 33; ++k) a += *(const f32x4*)(zf + k * 32 + 4 * qg) * w1[k * 64 + j];
        f32x4 o; for (int x = 0; x < 4; ++x) o[x] = sin_(fj * a[x]); *(f32x4*)(h1 + j * 32 + 4 * qg) = o; }
      __syncthreads();
      { f32x4 a = {b2[j], b2[j], b2[j], b2[j]};
#pragma unroll 8
        for (int k = 0; k < 64; ++k) a += *(const f32x4*)(h1 + k * 32 + 4 * qg) * w2[k * 64 + j];
        f32x4 o; for (int x = 0; x < 4; ++x) o[x] = sin_(fj * a[x]); *(f32x4*)(h2 + j * 32 + 4 * qg) = o; }
      __syncthreads();
      { f32x4 a = {b3[j], b3[j], b3[j], b3[j]};
#pragma unroll 8
        for (int k = 0; k < 64; ++k) a += *(const f32x4*)(h2 + k * 32 + 4 * qg) * w3[k * 64 + j];
        f32x4 o; for (int x = 0; x < 4; ++x) o[x] = sin_(fj * a[x]); *(f32x4*)(h1 + j * 32 + 4 * qg) = o; } }
    __syncthreads();
    const int pg = tid & 3, cg = tid >> 2, pos0 = p0 + 8 * pg; float delta[4];
#pragma unroll
    for (int cc = 0; cc < 4; ++cc) delta[cc] = 3.0701134573253945f + (float)(4 * cg + cc) * ((15.350567286626973f - 3.0701134573253945f) / 511.f);
    bf16_t* FTb = WSP(bf16_t, WS_FT) + (size_t)layer * 512 * 32768; float* FTC = WSP(float, WS_FTC) + (size_t)layer * 2 * 512 * 256;
#pragma unroll 1
    for (int dir = 0; dir < 2; ++dir) { const int n0 = dir * 512 + 4 * cg; f32x4 a[8];
#pragma unroll
        for (int q = 0; q < 8; ++q) a[q] = (f32x4){0.f, 0.f, 0.f, 0.f};
#pragma unroll 1
        for (int k0 = 0; k0 < 64; k0 += 8) { f32x4 wv[8];
#pragma unroll
            for (int kk = 0; kk < 8; ++kk) wv[kk] = *(const f32x4*)(w4 + (k0 + kk) * 1024 + n0);
#pragma unroll
            for (int kk = 0; kk < 8; ++kk) { const f32x4 hA = *(const f32x4*)(h1 + (k0 + kk) * 32 + 8 * pg), hB = *(const f32x4*)(h1 + (k0 + kk) * 32 + 8 * pg + 4);
#pragma unroll
                for (int q = 0; q < 4; ++q) { a[q] += wv[kk] * hA[q]; a[4 + q] += wv[kk] * hB[q]; } } }
        f32x4 asum = {0.f, 0.f, 0.f, 0.f};
#pragma unroll
        for (int q = 0; q < 8; ++q) { const int pos = pos0 + q; const float tt = (float)pos / (float)(L - 1);
#pragma unroll
            for (int cc = 0; cc < 4; ++cc) { const float h = a[q][cc] * __expf(-tt * delta[cc]); asum[cc] += fabsf(h); a[q][cc] = (dir == 1 && pos == 0) ? 0.f : h;
                if (isc) FTC[(size_t)(n0 + cc) * 256 + pos] = h; } }
        if (!isc) {
#pragma unroll
            for (int cc = 0; cc < 4; ++cc) { u32x4 o;
#pragma unroll
                for (int w = 0; w < 4; ++w) o[w] = dir == 0 ? pk2(a[7 - 2 * w][cc], a[6 - 2 * w][cc]) : pk2(a[2 * w][cc], a[2 * w + 1][cc]);
                *(u32x4*)(FTb + (size_t)(4 * cg + cc) * 32768 + (dir == 0 ? SEQ - 8 - pos0 : SEQ + pos0)) = o; } }
#pragma unroll
        for (int cc = 0; cc < 4; ++cc) { asum[cc] += __shfl_xor(asum[cc], 1); asum[cc] += __shfl_xor(asum[cc], 2); }
        if (pg == 0) *(f32x4*)(WSP(float, WS_FSUM) + (size_t)layer * 520 * 1024 + (size_t)item * 1024 + n0) = asum; }
    __syncthreads();
}
struct HcB { bf16x8 b0, b1; };
__device__ __forceinline__ HcB hc_ldB(const char* Zs, int Jp, int roff, int r32, int hi) {
    const int Jc = min(max(Jp, -1), 16); const int s1p = 32 * Jc + r32 + roff + 64, sw = (s1p >> 2) & 3;
    HcB o; o.b0 = *(const bf16x8*)(Zs + s1p * 64 + ((hi ^ sw) << 4)); o.b1 = *(const bf16x8*)(Zs + s1p * 64 + (((2 + hi) ^ sw) << 4));
    return o;
}
__device__ __forceinline__ bf16x8 hc_ld8(const bf16_t* Gf, int a, bool s2, unsigned sel) {
    const u32x2* q = (const u32x2*)(Gf + (a & ~3)); const u32x2 w0 = q[0], w1 = q[1], w2 = q[2];
    const unsigned t0 = s2 ? w0.y : w0.x, t1 = s2 ? w1.x : w0.y, t2 = s2 ? w1.y : w1.x, t3 = s2 ? w2.x : w1.y, t4 = s2 ? w2.y : w2.x;
    u32x4 o; o.x = __builtin_amdgcn_perm(t1, t0, sel); o.y = __builtin_amdgcn_perm(t2, t1, sel); o.z = __builtin_amdgcn_perm(t3, t2, sel); o.w = __builtin_amdgcn_perm(t4, t3, sel);
    return *reinterpret_cast<bf16x8*>(&o);
}
__device__ __forceinline__ void hc_ldA(bf16x8& A0, bf16x8& A1, const bf16_t* Gf, int abase, int d) {
    if (d != 0) { const int a = abase - (d > 0 ? 1 : 0) - 32 * d; const bool s2 = (a & 2) != 0; const unsigned sel = (a & 1) ? 0x05040302u : 0x03020100u;
        A0 = hc_ld8(Gf, a, s2, sel); A1 = hc_ld8(Gf, a + 16, s2, sel); }
    else { const int tau0 = SEQ - abase;
#pragma unroll
        for (int j = 0; j < 8; ++j) { const int ta = tau0 - j, tb = tau0 - 16 - j; A0[j] = (short)Gf[SEQ - ta - (ta >= 0 ? 1 : 0)]; A1[j] = (short)Gf[SEQ - tb - (tb >= 0 ? 1 : 0)]; } }
}
template <bool ANTI, bool TRI>
__device__ __forceinline__ void hc_block(f32x16 (&acc)[4], HcB (&W)[4], bf16x8& A0, bf16x8& A1, const bf16_t* Gf, const char* Zs, int abase, int r, int tq, int Q, bool skip_first, int r32, int hi) {
#pragma unroll
    for (int qq = 0; qq < 4; ++qq) { const int q = 4 * Q + qq;
        const int dn = ANTI ? -(r + 32 * (q + 1)) : (r + 32 * (q + 1)); const int dnc = min(max(dn, -511), 511);
        bf16x8 nA0, nA1; hc_ldA(nA0, nA1, Gf, abase, dnc);
        const HcB nb = ANTI ? hc_ldB(Zs, 4 * tq + 4 + q, r, r32, hi) : hc_ldB(Zs, 4 * tq - q - 1, -r, r32, hi);
        if (!(skip_first && q == 0)) {
#pragma unroll
            for (int i = 0; i < 4; ++i) { const bool valid = TRI ? (ANTI ? (i <= 3 - qq) : (i >= qq)) : true;
                if (valid) { const int slot = ANTI ? ((i + qq) & 3) : ((i - qq) & 3);
                    acc[i] = __builtin_amdgcn_mfma_f32_32x32x16_bf16(A0, W[slot].b0, acc[i], 0, 0, 0); acc[i] = __builtin_amdgcn_mfma_f32_32x32x16_bf16(A1, W[slot].b1, acc[i], 0, 0, 0); } } }
        W[ANTI ? (qq & 3) : ((-qq - 1) & 3)] = nb; A0 = nA0; A1 = nA1;
    }
}
__device__ __forceinline__ void hc_wave(f32x16 (&acc)[4], const bf16_t* Gf, const char* Zs, int tq, int rc, int r32, int hi) {
    const int abase = SEQ - (r32 - 8 * hi);
#pragma unroll 1
    for (int k = 0; k < 16; ++k) { const int r = rc + 2 * k; HcB W[4]; bf16x8 A0, A1;
#pragma unroll
        for (int j = 0; j < 4; ++j) W[j] = hc_ldB(Zs, 4 * tq + j, -r, r32, hi);
        hc_ldA(A0, A1, Gf, abase, r);
#pragma unroll 1
        for (int Q = 0; Q < tq; ++Q) hc_block<false, false>(acc, W, A0, A1, Gf, Zs, abase, r, tq, Q, false, r32, hi);
        hc_block<false, true>(acc, W, A0, A1, Gf, Zs, abase, r, tq, tq, false, r32, hi);
#pragma unroll
        for (int j = 0; j < 4; ++j) W[j] = hc_ldB(Zs, 4 * tq + j, r, r32, hi);
        hc_ldA(A0, A1, Gf, abase, -r);
#pragma unroll 1
        for (int Q = 0; Q < 3 - tq; ++Q) hc_block<true, false>(acc, W, A0, A1, Gf, Zs, abase, r, tq, Q, (r == 0) && (Q == 0), r32, hi);
        hc_block<true, true>(acc, W, A0, A1, Gf, Zs, abase, r, tq, 3 - tq, (r == 0) && (tq == 3), r32, hi);
    }
}
__device__ __forceinline__ void hyena_conv_unit(const Params& p, int layer, int ch, char* smem) {
    const int tid = ltid(), wid = __builtin_amdgcn_readfirstlane(tid >> 6), lane = tid & 63, r32 = lane & 31, hi = lane >> 5;
    bf16_t* Gf = (bf16_t*)smem; char* Zs = smem + 65536; float* red = (float*)smem; float* sred = (float*)(smem + 65536 + 40960);
    { const u32x4* src = (const u32x4*)(WSP(bf16_t, WS_FT) + (size_t)layer * 512 * 32768 + (size_t)ch * 32768); u32x4* dst = (u32x4*)Gf;
#pragma unroll
      for (int q = 0; q < 8; ++q) dst[tid + q * NTH] = src[tid + q * NTH];
      const u32x4* zs = (const u32x4*)(WSP(bf16_t, WS_ZT) + (size_t)ch * MALL);
#pragma unroll
      for (int q = 0; q < 4; ++q) { const int ci = tid + q * NTH, s1p = (ci >> 2) + 64, c = ci & 3; *(u32x4*)(Zs + s1p * 64 + ((c ^ ((s1p >> 2) & 3)) << 4)) = zs[ci]; }
      { const int row = tid >> 2, c = tid & 3; const int s1p = row < 64 ? row : 512 + row; unsigned z0 = 0u; asm volatile("" : "+v"(z0)); *(u32x4*)(Zs + s1p * 64 + (c << 4)) = (u32x4){z0, z0, z0, z0}; }
      const float* fs = WSP(float, WS_FSUM) + (size_t)layer * 520 * 1024 + (size_t)tid * 1024; float a = fs[ch] + fs[512 + ch]; a = wave_sum(a); if (lane == 0) sred[wid] = a; }
    __syncthreads();
    float tot = 0.f;
#pragma unroll
    for (int w = 0; w < 8; ++w) tot += sred[w];
    const float inv = 1.f / tot;
    const int tq = wid >> 1, rc = wid & 1;
    f32x16 acc[4] = {};
    hc_wave(acc, Gf, Zs, tq, rc, r32, hi);
    __syncthreads();
    if (rc == 1) {
#pragma unroll
        for (int i = 0; i < 4; ++i)
#pragma unroll
            for (int r = 0; r < 16; ++r) red[((tq * 4 + i) * 16 + r) * 64 + lane] = acc[i][r]; }
    __syncthreads();
    if (rc == 0) {
#pragma unroll
        for (int i = 0; i < 4; ++i)
#pragma unroll
            for (int r = 0; r < 16; ++r) red[((tq * 4 + i) * 16 + r) * 64 + lane] += acc[i][r]; }
    __syncthreads();
    { int ch2 = ch, t2i = tid; asm volatile("" : "+v"(ch2), "+v"(t2i) :: "memory"); ch2 = __builtin_amdgcn_readfirstlane(ch2);
      const float bias = p.in[25][layer * 512 + ch2]; const bf16_t* X0 = WSP(bf16_t, WS_X0T) + (size_t)ch2 * MALL; bf16_t* Y = WSP(bf16_t, WS_YS) + (size_t)3 * MALL * 512 + ch2;
#pragma unroll 4
      for (int k = 0; k < 32; ++k) { const int idx = t2i + NTH * k, ln = idx & 63, r = (idx >> 6) & 15, J = idx >> 10;
          const int t1 = 32 * J + (ln & 31), t2 = att::crow(r, ln >> 5), pos = 32 * t1 + t2;
          const int t1p = t1 + 64; const float zv = bf2f(*(const bf16_t*)(Zs + t1p * 64 + (((t2 >> 3) ^ ((t1p >> 2) & 3)) << 4) + (t2 & 7) * 2));
          Y[(size_t)pos * 512] = f2bf(bf2f(X0[pos]) * (red[idx] * inv + zv * bias)); } }
    __syncthreads();
}
__device__ __forceinline__ void hyena_ctx_item(const Params& p, int layer, int item, char* smem) {
    const int tid = ltid(), cl = tid >> 8, ch = item * 2 + cl, t = tid & 255; float* sred = (float*)smem; float* F0s = sred + 16; float* F1s = F0s + 512; float* Zl = F1s + 512;
    if (tid < 16) { const int c2 = item * 2 + (tid >> 3), it = 512 + (tid & 7); const float* fsl = WSP(float, WS_FSUM) + (size_t)layer * 520 * 1024; sred[tid] = fsl[(size_t)it * 1024 + c2] + fsl[(size_t)it * 1024 + 512 + c2]; }
    const float* FTC = WSP(float, WS_FTC) + (size_t)layer * 2 * 512 * 256;
    F0s[tid] = FTC[(size_t)ch * 256 + t]; F1s[tid] = FTC[(size_t)(512 + ch) * 256 + t];
    const float zt = bf2f(WSP(bf16_t, WS_ZT)[(size_t)ch * MALL + SEQ + t]); Zl[tid] = zt;
    __syncthreads();
    float tot = 0.f; for (int w = 0; w < 8; ++w) tot += sred[cl * 8 + w];
    const float* f0 = F0s + cl * 256; const float* f1 = F1s + cl * 256; const float* zl = Zl + cl * 256; float a = 0.f;
#pragma unroll 8
    for (int s = 0; s < 256; ++s) { const float ka = f0[max(t - s, 0)], kb = f1[max(s - t, 0)]; a += zl[s] * ((t >= s) ? ka : kb); }
    const float x0 = bf2f(WSP(bf16_t, WS_X0T)[(size_t)ch * MALL + SEQ + t]);
    WSP(bf16_t, WS_YS)[(size_t)3 * MALL * 512 + (size_t)(SEQ + t) * 512 + ch] = f2bf(x0 * (a / tot + zt * p.in[25][layer * 512 + ch]));
    __syncthreads();
}

#ifndef REP_SYNC
#define REP_SYNC 0
#endif
#ifndef REP_XN
#define REP_XN 1
#endif
#ifndef REP_HZ
#define REP_HZ 1
#endif
#ifndef REP_MODP
#define REP_MODP 1
#endif
#ifndef REP_FIN
#define REP_FIN 1
#endif
#ifndef REP_QKD
#define REP_QKD 0
#endif
#ifndef REP_CONV
#define REP_CONV 1
#endif
#ifndef REP_PG
#define REP_PG 1
#endif
#ifndef REP_GQA
#define REP_GQA 1
#endif
#ifndef REP_NA
#define REP_NA 1
#endif
#ifndef REP_HC
#define REP_HC 1
#endif
#ifndef REP_GLA3
#define REP_GLA3 1
#endif
#ifndef REP_GLA1
#define REP_GLA1 1
#endif
#ifndef REP_HF
#define REP_HF 1
#endif
#ifndef REP_HID
#define REP_HID 1
#endif
#ifndef REP_UP
#define REP_UP 1
#endif
#ifndef REP_MERGE
#define REP_MERGE 1
#endif
template <class E, class S> __device__ __forceinline__ void run_gemm(char* smem, const bf16_t* A, const bf16_t* Bt, int M, int N, int K, const S& s, const E& e) {
    pg8::Gemm g{A, Bt, M, N, K};
    pg8::gemm_phase<E, S, true, true>((PG8_LAS unsigned char*)smem, g, s, e);
}

__global__ void __launch_bounds__(NTH, 2) mega(Params p_arg) {
    extern __shared__ __attribute__((aligned(16))) char smem[];
    cg::grid_group grid = cg::this_grid();
    const int bid = blockIdx.x, G = gridDim.x;
    volatile __attribute__((address_space(3))) unsigned* xst = (volatile __attribute__((address_space(3))) unsigned*)(smem + LDS_BYTES - 64);
    if (threadIdx.x < 2) xst[threadIdx.x] = 0u;
    __syncthreads();
    const XcdBarrier xbar = xcd_barrier_post((unsigned*)(p_arg.ws + WS_CTL + 1024), xst);
    int ph = 0;
    const int ph_lo = p_arg.ph_lo, ph_hi = p_arg.ph_hi;
    typedef const Params __attribute__((address_space(4)))* KP;
#define PHASE_BEGIN if (ph >= ph_lo && ph < ph_hi) { KP kp_ = (KP)__builtin_amdgcn_kernarg_segment_ptr(); asm volatile("" : "+s"(kp_) :: "memory"); Params p; __builtin_memcpy(&p, kp_, sizeof(Params)); \
    bf16_t* P = WSP(bf16_t, WS_P); const float* in_x = p.in[0]; const float* in_ctx = p.in[2]; float* outp = p.out; float* hcp = WSP(float, WS_HC); const float* mod = WSP(float, WS_MOD) + (size_t)layer * 2 * 12288; const int tid = ltid(); (void)P; (void)in_x; (void)in_ctx; (void)outp; (void)hcp; (void)mod; (void)tid;
#define PHASE_END   if (ph + 1 < ph_hi) { if (ph == 0) grid.sync(); else xcd_barrier(xbar); } } ++ph;
    { const int layer = 0; PHASE_BEGIN for (int rep = 0; rep < REP_MODP; ++rep) mod_partials(p, smem); for (int rep = 0; rep < REP_CONV; ++rep) convert_weights(p, 0, smem, 0, 0); PHASE_END }
#pragma unroll
    for (int layer = 0; layer < 2; ++layer) {
        const int Mr = layer == 0 ? MALL : SEQ;
        PHASE_BEGIN if (layer == 1) for (int rep = 0; rep < REP_CONV; ++rep) convert_weights(p, 1, smem, 2, 0); for (int rep = 0; rep < REP_XN; ++rep) xn_phase(p, layer, 0, smem); for (int rep = 0; rep < REP_SYNC; ++rep) xcd_barrier(xbar); PHASE_END
        PHASE_BEGIN for (int rep = 0; rep < REP_PG; ++rep) { pg8::StaticOrder S; S.init(MALL, LDP, G, bid); EpiStore E{P, LDP, NPM / 256}; run_gemm(smem, WSP(bf16_t, WS_XN), WSP(bf16_t, WS_WIN), MALL, LDP, DM, S, E); } PHASE_END
        PHASE_BEGIN
            for (int it = bid; it < MALL / 8; it += G) qk_item(p, layer, it);
            for (int rep = 0; rep < REP_GLA1; ++rep) for (int it = (bid + 64) % G; it < 8 * NCHUNK; it += G) gla_local_item(p, layer, it, smem);
            for (int rep = 0; rep < REP_HZ; ++rep) for (int it = (bid + 128) % G; it < MALL / 32; it += G) hyena_z_item(p, layer, it, smem);
            if (layer == 0) for (int rep = 0; rep < REP_HF; ++rep) { hyena_filter_prep(p, layer, smem); for (int it = (bid + 192) % G; it < 520; it += G) hyena_filter_item(p, layer, it, smem); }
        PHASE_END
        PHASE_BEGIN
            for (int it = (bid + 128) % G; it < 128; it += G) gla_scan_item(p, layer, it);
            bf16_t* YS = WSP(bf16_t, WS_YS);
            att::NaInfo na0{0, 0, 1, nullptr};
            for (int rep = 0; rep < REP_GQA; ++rep) for (int u = bid; u < 256; u += G) {
                const int xcd = u & 7, kvh = xcd >> 2, uu = (xcd & 3) * 32 + (u >> 3), head = 2 * kvh + (uu >> 6), qt = uu & 63;
                att::attn_body<0, 2>(P + (size_t)qt * 256 * LDP + C_AQ + head * 128, P + C_AK + kvh * 128, P + C_AV + kvh * 128,
                                  YS + (size_t)qt * 256 * 512 + head * 128, MALL / 64, smem, na0);
            }
            if (layer == 0) for (int u = (bid + 192) % G; u < 8; u += G) {
                const int head = u & 3;
                if (u < 4) att::attn_body<0, 2>(P + (size_t)SEQ * LDP + C_AQ + head * 128, P + (size_t)SEQ * LDP + C_AK + (head >> 1) * 128, P + (size_t)SEQ * LDP + C_AV + (head >> 1) * 128,
                                             YS + (size_t)SEQ * 512 + head * 128, 4, smem, na0);
                else att::attn_body<0, 2>(P + (size_t)SEQ * LDP + C_BQ + head * 128, P + (size_t)SEQ * LDP + C_BK + head * 128, P + (size_t)SEQ * LDP + C_BV + head * 128,
                                       YS + (size_t)MALL * 512 + (size_t)SEQ * 512 + head * 128, 4, smem, na0);
            }
            for (int rep = 0; rep < REP_NA; ++rep) for (int u = bid; u < 256; u += G) {
                const int head = u >> 6, qt = u & 63, r0 = qt * 4;
                float* bl = (float*)(smem + att::SHM_ATTN);
                { const int t_ = ltid(); if (t_ < 465) bl[t_] = p.in[11][(size_t)(layer * 4 + head) * 465 + t_] * (1.f / att::SCALE); }
                __syncthreads();
                const int rs0 = min(max(r0 - 4, 0), 248), rse = min(max(r0 + 3 - 4, 0), 248) + 8, nloc = rse - rs0;
                att::NaInfo na{r0, rs0, nloc, bl};
                att::attn_body<1, 1>(P + (size_t)qt * 256 * LDP + C_BQ + head * 128, P + C_BK + head * 128, P + C_BV + head * 128,
                                  YS + (size_t)MALL * 512 + (size_t)qt * 256 * 512 + head * 128, (4 + nloc + 1) & ~1, smem, na);
            }
            for (int rep = 0; rep < REP_HC; ++rep) for (int c0 = bid; c0 < 512; c0 += G) {
                const int cl = c0 & 255, ch = (G == 256) ? ((cl & 7) * 32 + (cl >> 3) + (c0 & 256)) : c0; hyena_conv_unit(p, layer, ch, smem); }
            if (layer == 0) for (int it = bid; it < 256; it += G) hyena_ctx_item(p, layer, it, smem);
            gla_scan_wait(p, layer);
            for (int rep = 0; rep < REP_GLA3; ++rep) for (int it = (bid + 64) % G; it < 4 * (layer == 0 ? 260 : 256); it += G) gla_out_item(p, layer, it, smem);
        PHASE_END
        PHASE_BEGIN for (int rep = 0; rep < REP_MERGE; ++rep) { MergeOrder S; S.init(Mr, G, bid); EpiMerge E{WSP(bf16_t, WS_MG), P + NPM}; run_gemm(smem, WSP(bf16_t, WS_YS), WSP(bf16_t, WS_WBR), 4 * MALL, 4 * DM, 512, S, E); }
            if (layer == 0) { const int b0 = G > 16 ? 8 : 0; if (bid >= b0) { hyena_filter_prep(p, 1, smem); for (int it = 512 - 1 - (bid - b0); it >= 0; it -= (G - b0)) hyena_filter_item(p, 1, it, smem); } }
        PHASE_END
        PHASE_BEGIN { pg8::StaticOrder S; S.init(Mr, DM, G, bid);
            EpiResid E{layer == 0 ? in_x : (const float*)outp, outp, layer == 0 ? in_ctx : (const float*)hcp, hcp, mod + 4096, mod + 12288 + 4096};
            run_gemm(smem, WSP(bf16_t, WS_MG), WSP(bf16_t, WS_WOUT), Mr, DM, DM, S, E); } PHASE_END
        PHASE_BEGIN for (int rep = 0; rep < REP_XN; ++rep) xn_phase(p, layer, 1, smem); PHASE_END
        PHASE_BEGIN for (int rep = 0; rep < REP_UP; ++rep) { pg8::StaticOrder S; S.init(Mr, NUP, G, bid); EpiHid E{WSP(bf16_t, WS_HID), WSP(bf16_t, WS_U), p.in[29] + (size_t)layer * 3 * NUP, p.in[30] + (size_t)layer * NUP}; run_gemm(smem, WSP(bf16_t, WS_XN), WSP(bf16_t, WS_WUP), Mr, NUP, DM, S, E); } PHASE_END
        PHASE_BEGIN hid_fix_phase(p, layer, Mr); PHASE_END
        PHASE_BEGIN { pg8::StaticOrder S; S.init(Mr, DM, G, bid);
            EpiResid E{outp, outp, hcp, hcp, mod + 10240, mod + 12288 + 10240};
            run_gemm(smem, WSP(bf16_t, WS_HID), WSP(bf16_t, WS_WDN), Mr, DM, DFF, S, E);
            if (layer == 0) convert_weights(p, 1, smem, 1, G > 16 ? 8 : 0); } PHASE_END
    }
    { const int layer = 0; PHASE_BEGIN for (int rep = 0; rep < REP_FIN; ++rep) final_norm(p); PHASE_END }
}

extern "C" void kernel_launch(void* const* d_in, const int* in_sizes, int n_in, void* d_out, int out_size, void* d_ws, size_t ws_size, hipStream_t stream) {
    static int grid_blocks = 0;
    if (grid_blocks == 0) {
        if (n_in != 33 || ws_size < WS_END) { fprintf(stderr, "kernel_launch: n_in %d ws %zu (need %zu)\n", n_in, ws_size, (size_t)WS_END); grid_blocks = -1; return; }
        int dev = 0, cus = 0, per_cu = 0;
        hipGetDevice(&dev); hipDeviceGetAttribute(&cus, hipDeviceAttributeMultiprocessorCount, dev);
        if (hipFuncSetAttribute((const void*)mega, hipFuncAttributeMaxDynamicSharedMemorySize, LDS_BYTES) != hipSuccess) { fprintf(stderr, "kernel_launch: LDS attribute failed\n"); grid_blocks = -1; return; }
        hipOccupancyMaxActiveBlocksPerMultiprocessor(&per_cu, (const void*)mega, NTH, LDS_BYTES);
        if (per_cu < 1) per_cu = 1;
        grid_blocks = cus * per_cu;
    }
    if (grid_blocks < 0) return;
    if (hipMemsetAsync((char*)d_ws + WS_CTL, 0, 16384, stream) != hipSuccess) { fprintf(stderr, "memset failed\n"); return; }
    Params p{};
    for (int i = 0; i < 33; ++i) p.in[i] = (const float*)d_in[i];
    p.out = (float*)d_out; p.ws = (unsigned char*)d_ws; p.ph_lo = 0; p.ph_hi = 1000;
    void* args[] = {&p};
    hipError_t e = hipLaunchCooperativeKernel((const void*)mega, dim3(grid_blocks), dim3(NTH), args, LDS_BYTES, stream);
    if (e != hipSuccess) fprintf(stderr, "cooperative launch failed: %s (grid %d)\n", hipGetErrorString(e), grid_blocks);
}
```

```cpp
#include <hip/hip_runtime.h>
#include <hip/hip_cooperative_groups.h>
#include <cstdint>
#include <cstdio>
namespace cg = cooperative_groups;

typedef unsigned short bf16_t;
typedef short bf16x8 __attribute__((ext_vector_type(8)));
typedef short s16x4 __attribute__((ext_vector_type(4)));
typedef float f32x4 __attribute__((ext_vector_type(4)));
typedef float f32x16 __attribute__((ext_vector_type(16)));
typedef unsigned u32x4 __attribute__((ext_vector_type(4)));
typedef unsigned u32x2 __attribute__((ext_vector_type(2)));

constexpr int DM = 2048, SEQ = 16384, CTXL = 256, MALL = SEQ + CTXL, LDP = 14080, NPM = 5888, INW = 13856, NMIX = 5664, DFF = 5632, NUP = 11264;
constexpr int C_AQ = 0, C_AK = 512, C_AV = 768, C_BQ = 1024, C_BK = 1536, C_BV = 2048, C_CQ = 2560, C_CK = 2816, C_CV = 3072, C_CA = 3584, C_CG = 3616, C_DU = 4128;
constexpr int NTH = 512;
constexpr int LDS_BYTES = 135168;
constexpr int KS = 16;
constexpr int NCHUNK = MALL / 64;

constexpr size_t WS_CTL  = 0;
constexpr size_t WS_MODP = 16384;
constexpr size_t WS_MOD  = WS_MODP + (size_t)KS * 2 * 2 * 12288 * 4;
constexpr size_t WS_HC   = WS_MOD + (size_t)2 * 2 * 12288 * 4;
constexpr size_t WS_FSUM = WS_HC + (size_t)CTXL * DM * 4;
constexpr size_t WS_FT   = WS_FSUM + (size_t)2 * 520 * 1024 * 4;
constexpr size_t WS_FTC  = WS_FT + (size_t)2 * 512 * 32768 * 2;
constexpr size_t WS_GD   = WS_FTC + (size_t)2 * 2 * 512 * 256 * 4;
constexpr size_t WS_WIN  = WS_GD + (size_t)8 * NCHUNK * 64 * 4;
constexpr size_t WS_WBR  = WS_WIN + (size_t)LDP * DM * 2;
constexpr size_t WS_WOUT = WS_WBR + (size_t)4 * DM * 512 * 2;
constexpr size_t WS_WUP  = WS_WOUT + (size_t)DM * DM * 2;
constexpr size_t WS_WDN  = WS_WUP + (size_t)NUP * DM * 2;
constexpr size_t WS_P    = WS_WDN + (size_t)DM * DFF * 2;
constexpr size_t WS_XN   = WS_P + (size_t)MALL * LDP * 2;
constexpr size_t WS_YS   = WS_XN + (size_t)MALL * DM * 2;
constexpr size_t WS_MG   = WS_YS + (size_t)4 * MALL * 512 * 2;
constexpr size_t WS_END  = WS_MG + (size_t)MALL * DM * 2;
constexpr size_t WS_U    = WS_P;
constexpr size_t WS_HID  = WS_P + 33554432;
constexpr size_t WS_GS   = WS_XN;
constexpr size_t WS_ZT   = WS_MG;
constexpr size_t WS_X0T  = WS_MG + (size_t)512 * MALL * 2;
static_assert((size_t)8 * NCHUNK * 64 * 128 * 4 <= (size_t)MALL * DM * 2, "GLA states fit XN");
static_assert(33554432 + (size_t)MALL * DFF * 2 <= (size_t)MALL * LDP * 2 && (size_t)(MALL / 64) * 4 * NUP * 2 <= 33554432, "raw + hidden fit the P region");
static_assert((size_t)MALL * NUP * 2 <= (size_t)MALL * LDP * 2, "U fits P");
static_assert(WS_END <= 900000000ull, "workspace budget");

__device__ __forceinline__ float bf2f(bf16_t u) { return __uint_as_float((unsigned)u << 16); }
__device__ __forceinline__ unsigned pk2(float lo, float hi) { unsigned r; asm volatile("v_cvt_pk_bf16_f32 %0, %1, %2" : "=v"(r) : "v"(lo), "v"(hi)); return r; }
__device__ __forceinline__ bf16_t f2bf(float a) { return (bf16_t)(pk2(a, a) & 0xffffu); }
__device__ __forceinline__ float wave_sum(float v) {
#pragma unroll
    for (int o = 1; o < 64; o <<= 1) v += __shfl_xor(v, o);
    return v;
}
__device__ __forceinline__ float sigmoidf_(float x) { return 1.f / (1.f + __expf(-x)); }
__device__ __forceinline__ float siluf_(float x) { return x / (1.f + __expf(-x)); }

__device__ __forceinline__ void sincos_(float x, float& s, float& c) {
    const float kf = rintf(x * 0.6366197723675814f); const int k = (int)kf;
    float r = fmaf(-kf, 1.5703125f, x); r = fmaf(-kf, 4.837512969970703125e-4f, r); r = fmaf(-kf, 7.54978995e-8f, r);
    const float r2 = r * r;
    const float sp = r + r * r2 * (-1.6666654611e-1f + r2 * (8.3321608736e-3f + r2 * (-1.9515295891e-4f)));
    const float cp = 1.f - 0.5f * r2 + r2 * r2 * (4.166664568298827e-2f + r2 * (-1.388731625493765e-3f + r2 * 2.443315711809948e-5f));
    float ss = (k & 1) ? cp : sp, cc = (k & 1) ? sp : cp;
    if (k & 2) ss = -ss;
    if ((k + 1) & 2) cc = -cc;
    s = ss; c = cc;
}
__device__ __forceinline__ float sin_(float x) { float s, c; sincos_(x, s, c); return s; }
__device__ __forceinline__ float cos_(float x) { float s, c; sincos_(x, s, c); return c; }

__device__ __forceinline__ int ltid() { int t = threadIdx.x; asm volatile("" : "+v"(t)); return t; }

__device__ __forceinline__ int lbid() { int b = blockIdx.x; asm volatile("" : "+s"(b)); return b; }

struct Params { const float* in[33]; float* out; unsigned char* ws; int ph_lo, ph_hi; };

namespace pg8 {
#define PG8_LAS __attribute__((address_space(3)))
typedef unsigned short bf16_t;
typedef short bf16x8 __attribute__((ext_vector_type(8)));
typedef float f32x4 __attribute__((ext_vector_type(4)));
typedef unsigned u32x4 __attribute__((ext_vector_type(4)));
constexpr int BM = 256, BK = 64, HALF = 128, HTB = HALF * BK * 2  , STAGE_BYTES = 8 * HTB, NXCD = 8, WGM = 8;

__host__ __device__ __forceinline__ int lds_byte(int r, int c) { const int st = (r >> 4) * 2 + (c >> 5), rr = r & 15, cc = c & 31, ob = rr * 64 + cc * 2; return st * 1024 + (ob ^ (((ob >> 9) & 1) << 5)); }
__host__ __device__ __forceinline__ void stage_rc(int b, int& R, int& C) { const int st = b / 1024, sb = b % 1024, swz = sb ^ (((sb >> 9) & 1) << 5); R = (st >> 1) * 16 + swz / 64; C = (st & 1) * 32 + (swz % 64) / 2; }
__host__ __device__ __forceinline__ int perm32(int rho) { const int n = rho >> 4, i = rho & 15; return 8 * (i >> 2) + 4 * n + (i & 3); }

struct Unit { int pm, pn; };
struct Gemm { const bf16_t* A; const bf16_t* Bt; int M, N, K; };

struct StaticOrder {
    int nM, nN, nwg, G, c;
    __host__ __device__ void init(int M, int N, int G_, int c_) { nM = M / BM; nN = N / BM; nwg = nM * nN; G = G_; c = c_; }
    __host__ __device__ bool next(int i, Unit& u) const {
        const long L = (long)i * G + c; if (L >= nwg) return false;
        int wgid = (int)L; { const int q = nwg / NXCD, r = nwg % NXCD, xcd = wgid % NXCD, off = wgid / NXCD; wgid = (xcd < r ? xcd * (q + 1) : r * (q + 1) + (xcd - r) * q) + off; }
        const int nig = WGM * nN, gid = wgid / nig, fm = gid * WGM, gsz = (nM - fm) < WGM ? (nM - fm) : WGM;
        u.pm = fm + ((wgid % nig) % gsz); u.pn = (wgid % nig) / gsz; return true;
    }
    __device__ __forceinline__ void a_ready(const Unit&) const {}
    __device__ __forceinline__ void done(const Unit&) const {}
};

__device__ __forceinline__ unsigned cvt_pk_bf16(float lo, float hi) { unsigned r; asm volatile("v_cvt_pk_bf16_f32 %0, %1, %2" : "=v"(r) : "v"(lo), "v"(hi)); return r; }

template <class Epi, class Sched, bool ALIGN_EPI = false, bool SP2 = false>
__device__ __forceinline__ void gemm_phase(PG8_LAS unsigned char* lds, const Gemm g, const Sched& S, const Epi& E) {
    const int tid = ltid(), wid = __builtin_amdgcn_readfirstlane(tid >> 6), lane = tid & 63, wr = wid >> 2, wc = wid & 3, fr = lane & 15, fq = lane >> 4;
    const int K = g.K, nt = K / BK;
    unsigned voffA[2], voffB[2];
#pragma unroll
    for (int i = 0; i < 2; ++i) { int R, C; stage_rc(tid * 16 + i * 8192, R, C); const int Rb = Epi::PERM ? ((R & ~31) + perm32(R & 31)) : R;
        voffA[i] = (unsigned)(R * K + C) * 2u; voffB[i] = (unsigned)(Rb * K + C) * 2u; }
    const size_t kstep = (size_t)(BK * 2);
    const size_t hstep = (size_t)HALF * K * 2;
    const size_t tstep = 2 * hstep;
    const unsigned ldsw = (unsigned)wid * 1024u;
    const int aoff = lds_byte(wr * 64 + fr, fq * 8), boff = lds_byte(wc * 32 + fr, fq * 8);
#define PG8_SA(b, h) (((b) * 2 + (h)) * HTB)
#define PG8_SB(b, h) ((4 + (b) * 2 + (h)) * HTB)
#define PG8_STAGE(bufoff, gbase, voff) do { _Pragma("unroll") for (int _i = 0; _i < 2; ++_i) \
        __builtin_amdgcn_global_load_lds((const unsigned*)((const char*)(gbase) + (voff)[_i]), (PG8_LAS unsigned*)(lds + (bufoff) + ldsw + _i * 8192), 16, 0, 0); } while (0)
#define PG8_LDA(dst, b, h) do { _Pragma("unroll") for (int m = 0; m < 4; ++m) _Pragma("unroll") for (int k = 0; k < 2; ++k) dst[m][k] = *(const PG8_LAS bf16x8*)(lds + PG8_SA(b, h) + aoff + m * 2048 + k * 1024); } while (0)
#define PG8_LDB(dst, b, h) do { _Pragma("unroll") for (int n = 0; n < 2; ++n) _Pragma("unroll") for (int k = 0; k < 2; ++k) dst[n][k] = *(const PG8_LAS bf16x8*)(lds + PG8_SB(b, h) + boff + n * 2048 + k * 1024); } while (0)
#define PG8_MMA(ai, bj, At, Bt) do { __builtin_amdgcn_s_setprio(1); _Pragma("unroll") for (int m = 0; m < 4; ++m) _Pragma("unroll") for (int n = 0; n < 2; ++n) _Pragma("unroll") for (int k = 0; k < 2; ++k) \
        acc[ai][bj][m][n] = __builtin_amdgcn_mfma_f32_16x16x32_bf16(Bt[n][k], At[m][k], acc[ai][bj][m][n], 0, 0, 0); __builtin_amdgcn_s_setprio(0); } while (0)
#define PG8_WAIT_V(n) asm volatile("s_waitcnt vmcnt(" #n ")" ::: "memory")
#define PG8_WAIT_L(n) asm volatile("s_waitcnt lgkmcnt(" #n ")" ::: "memory")
#define PG8_BAR __builtin_amdgcn_s_barrier()
#define PG8_SCHED __builtin_amdgcn_sched_barrier(0)
    Unit cur, nxt; int ui = 0;
    if (!S.next(0, cur)) return;
    f32x4 acc[2][2][4][2];
#pragma unroll
    for (int a = 0; a < 2; ++a)
#pragma unroll
        for (int b = 0; b < 2; ++b)
#pragma unroll
            for (int m = 0; m < 4; ++m)
#pragma unroll
                for (int n = 0; n < 2; ++n) { float zr_ = 0.f; asm volatile("" : "+v"(zr_)); acc[a][b][m][n] = (f32x4){zr_, zr_, zr_, zr_}; }
    bf16x8 At[4][2], B0[2][2], B1[2][2];
    const char* cA = (const char*)g.A + (size_t)cur.pm * tstep; const char* cB = (const char*)g.Bt + (size_t)cur.pn * tstep;
    S.a_ready(cur);
    if constexpr (SP2) {
        PG8_STAGE(PG8_SB(0, 0), cB, voffB); PG8_STAGE(PG8_SB(0, 1), cB + hstep, voffB); PG8_STAGE(PG8_SA(0, 0), cA, voffA); PG8_STAGE(PG8_SA(0, 1), cA + hstep, voffA);
        if (wr == 1) PG8_BAR;
        PG8_WAIT_V(2); PG8_BAR;
        PG8_STAGE(PG8_SB(1, 0), cB + kstep, voffB); PG8_STAGE(PG8_SA(1, 0), cA + kstep, voffA); PG8_STAGE(PG8_SB(1, 1), cB + hstep + kstep, voffB);
        PG8_WAIT_V(6); PG8_BAR;
    } else {
        PG8_STAGE(PG8_SB(0, 0), cB, voffB); PG8_STAGE(PG8_SA(0, 0), cA, voffA); PG8_STAGE(PG8_SB(0, 1), cB + hstep, voffB); PG8_STAGE(PG8_SA(0, 1), cA + hstep, voffA);
        if (wr == 1) PG8_BAR;
        PG8_WAIT_V(4); PG8_BAR;
        PG8_STAGE(PG8_SB(1, 0), cB + kstep, voffB); PG8_STAGE(PG8_SA(1, 0), cA + kstep, voffA); PG8_STAGE(PG8_SB(1, 1), cB + hstep + kstep, voffB);
        PG8_WAIT_V(6); PG8_BAR;
    }
    for (;;) {
        const bool has_next = S.next(ui + 1, nxt);
        const char* nA = has_next ? (const char*)g.A + (size_t)nxt.pm * tstep : cA; const char* nB = has_next ? (const char*)g.Bt + (size_t)nxt.pn * tstep : cB;
        for (int t = 0; t < nt; t += 2) {
            const bool last = (t == nt - 2);
            const char* a1 = cA + (size_t)(t + 1) * kstep;
            const char* a2 = last ? nA : cA + (size_t)(t + 2) * kstep; const char* b2 = last ? nB : cB + (size_t)(t + 2) * kstep;
            const char* a3 = a2 + kstep; const char* b3 = b2 + kstep;
            if (last && has_next) S.a_ready(nxt);
            if constexpr (SP2) {
            PG8_LDB(B0, 0, 0); PG8_LDB(B1, 0, 1); PG8_SCHED; PG8_LDA(At, 0, 0); PG8_STAGE(PG8_SA(1, 1), a1 + hstep, voffA);
            PG8_WAIT_V(8); PG8_WAIT_L(0); PG8_BAR; PG8_MMA(0, 0, At, B0); PG8_MMA(0, 1, At, B1); PG8_BAR; PG8_SCHED;
            PG8_LDA(At, 0, 1); PG8_STAGE(PG8_SB(0, 0), b2, voffB); PG8_STAGE(PG8_SB(0, 1), b2 + hstep, voffB); PG8_STAGE(PG8_SA(0, 0), a2, voffA);
            PG8_WAIT_V(8); PG8_WAIT_L(0); PG8_BAR; PG8_MMA(1, 0, At, B0); PG8_MMA(1, 1, At, B1); PG8_BAR; PG8_SCHED;
            PG8_LDB(B0, 1, 0); PG8_LDB(B1, 1, 1); PG8_SCHED; PG8_LDA(At, 1, 0); PG8_STAGE(PG8_SA(0, 1), a2 + hstep, voffA);
            PG8_WAIT_V(8); PG8_WAIT_L(0); PG8_BAR; PG8_MMA(0, 0, At, B0); PG8_MMA(0, 1, At, B1); PG8_BAR; PG8_SCHED;
            PG8_LDA(At, 1, 1); PG8_STAGE(PG8_SB(1, 0), b3, voffB); PG8_STAGE(PG8_SB(1, 1), b3 + hstep, voffB); PG8_STAGE(PG8_SA(1, 0), a3, voffA);
            PG8_WAIT_V(8); PG8_WAIT_L(0); PG8_BAR; PG8_MMA(1, 0, At, B0); PG8_MMA(1, 1, At, B1); PG8_BAR; PG8_SCHED;
            } else {
            PG8_LDB(B0, 0, 0); PG8_SCHED; PG8_LDA(At, 0, 0); PG8_STAGE(PG8_SA(1, 1), a1 + hstep, voffA);
            PG8_WAIT_L(8); PG8_BAR; PG8_WAIT_L(0); PG8_MMA(0, 0, At, B0); PG8_BAR; PG8_SCHED;
            PG8_LDB(B1, 0, 1); PG8_STAGE(PG8_SB(0, 0), b2, voffB);
            PG8_BAR; PG8_WAIT_L(0); PG8_MMA(0, 1, At, B1); PG8_BAR;
            PG8_LDA(At, 0, 1); PG8_STAGE(PG8_SA(0, 0), a2, voffA);
            PG8_BAR; PG8_WAIT_L(0); PG8_MMA(1, 0, At, B0); PG8_BAR; PG8_SCHED;
            PG8_STAGE(PG8_SB(0, 1), b2 + hstep, voffB);
            PG8_WAIT_V(6); PG8_BAR; PG8_MMA(1, 1, At, B1); PG8_BAR;
            PG8_LDB(B0, 1, 0); PG8_SCHED; PG8_LDA(At, 1, 0); PG8_STAGE(PG8_SA(0, 1), a2 + hstep, voffA);
            PG8_WAIT_L(8); PG8_BAR; PG8_WAIT_L(0); PG8_MMA(0, 0, At, B0); PG8_BAR; PG8_SCHED;
            PG8_LDB(B1, 1, 1); PG8_STAGE(PG8_SB(1, 0), b3, voffB);
            PG8_BAR; PG8_WAIT_L(0); PG8_MMA(0, 1, At, B1); PG8_BAR;
            PG8_LDA(At, 1, 1); PG8_STAGE(PG8_SA(1, 0), a3, voffA);
            PG8_BAR; PG8_WAIT_L(0); PG8_MMA(1, 0, At, B0); PG8_BAR; PG8_SCHED;
            PG8_STAGE(PG8_SB(1, 1), b3 + hstep, voffB);
            PG8_WAIT_V(6); PG8_BAR; PG8_MMA(1, 1, At, B1); PG8_BAR;
            }
        }
        if constexpr (ALIGN_EPI) { if (wr == 0) PG8_BAR; }
        if constexpr (!Epi::AFTER_DRAIN) { E(acc, cur, wr, wc, fr, fq); S.done(cur); }
        if (!has_next) break;
#pragma unroll
        for (int a = 0; a < 2; ++a)
#pragma unroll
            for (int b = 0; b < 2; ++b)
#pragma unroll
                for (int m = 0; m < 4; ++m)
#pragma unroll
                    for (int n = 0; n < 2; ++n) { float zr_ = 0.f; asm volatile("" : "+v"(zr_)); acc[a][b][m][n] = (f32x4){zr_, zr_, zr_, zr_}; }
        cur = nxt; cA = nA; cB = nB; ++ui;
        if constexpr (ALIGN_EPI) { if (wr == 1) PG8_BAR; }
    }
    PG8_WAIT_V(0);
    if constexpr (!ALIGN_EPI) { if (wr == 0) PG8_BAR; }
    PG8_BAR;
    if constexpr (Epi::AFTER_DRAIN) { E.fused(acc, cur, wr, wc, fr, fq, lds, wid, lane); S.done(cur); }
#undef PG8_SA
#undef PG8_SB
#undef PG8_STAGE
#undef PG8_LDA
#undef PG8_LDB
#undef PG8_MMA
#undef PG8_WAIT_V
#undef PG8_WAIT_L
#undef PG8_BAR
#undef PG8_SCHED
}
}

struct EpiStore {
    static constexpr bool PERM = true, AFTER_DRAIN = false;
    bf16_t* O; int ldc; int sig_pn;
    __device__ __forceinline__ void operator()(const f32x4 (&acc)[2][2][4][2], const pg8::Unit& u, int wr, int wc, int fr, int fq) const {
        const int row0 = u.pm * 256 + wr * 64 + fr, col0 = u.pn * 256 + wc * 32 + 8 * fq; const bool sg = u.pn >= sig_pn;
#pragma unroll
        for (int ai = 0; ai < 2; ++ai)
#pragma unroll
            for (int m = 0; m < 4; ++m) { bf16_t* rowp = O + (size_t)(row0 + ai * 128 + m * 16) * ldc + col0;
#pragma unroll
                for (int bj = 0; bj < 2; ++bj) { f32x4 v0 = acc[ai][bj][m][0], v1 = acc[ai][bj][m][1];
                    if (sg) {
#pragma unroll
                        for (int e = 0; e < 4; ++e) { v0[e] = __builtin_amdgcn_rcpf(1.f + __expf(-v0[e])); v1[e] = __builtin_amdgcn_rcpf(1.f + __expf(-v1[e])); } }
                    u32x4 w; w.x = pk2(v0[0], v0[1]); w.y = pk2(v0[2], v0[3]); w.z = pk2(v1[0], v1[1]); w.w = pk2(v1[2], v1[3]);
                    *(u32x4*)(rowp + bj * 128) = w; } }
    }
};
struct EpiMerge {
    static constexpr bool PERM = true, AFTER_DRAIN = false;
    bf16_t* Mg; const bf16_t* Pg;
    __device__ __forceinline__ void operator()(const f32x4 (&acc)[2][2][4][2], const pg8::Unit& u, int wr, int wc, int fr, int fq) const {
        const int br = u.pn >> 3, pn = u.pn & 7, pm = u.pm - br * 65;
        const int row0 = pm * 256 + wr * 64 + fr, col0 = pn * 256 + wc * 32 + 8 * fq;
#pragma unroll
        for (int ai = 0; ai < 2; ++ai) { u32x4 gw[4][2], ow[4][2];
#pragma unroll
            for (int m = 0; m < 4; ++m)
#pragma unroll
                for (int bj = 0; bj < 2; ++bj) { const int row = row0 + ai * 128 + m * 16, col = col0 + bj * 128;
                    gw[m][bj] = *(const u32x4*)(Pg + (size_t)row * LDP + br * 2048 + col);
                    if (br) ow[m][bj] = *(const u32x4*)(Mg + (size_t)row * DM + col); else ow[m][bj] = (u32x4){0u, 0u, 0u, 0u}; }
#pragma unroll
            for (int m = 0; m < 4; ++m)
#pragma unroll
                for (int bj = 0; bj < 2; ++bj) { const int row = row0 + ai * 128 + m * 16, col = col0 + bj * 128;
                    const f32x4 v0 = acc[ai][bj][m][0], v1 = acc[ai][bj][m][1]; float r[8];
#pragma unroll
                    for (int e = 0; e < 4; ++e) { const float a0 = e < 2 ? v0[2 * e] : v1[2 * e - 4], a1 = e < 2 ? v0[2 * e + 1] : v1[2 * e - 3];
                        r[2 * e] = __uint_as_float(ow[m][bj][e] << 16) + __uint_as_float(gw[m][bj][e] << 16) * a0;
                        r[2 * e + 1] = __uint_as_float(ow[m][bj][e] & 0xffff0000u) + __uint_as_float(gw[m][bj][e] & 0xffff0000u) * a1; }
                    u32x4 w; w.x = pk2(r[0], r[1]); w.y = pk2(r[2], r[3]); w.z = pk2(r[4], r[5]); w.w = pk2(r[6], r[7]);
                    *(u32x4*)(Mg + (size_t)row * DM + col) = w; } }
    }
};
__device__ __forceinline__ float dpp_up(float cur, float prevreg) {
    const int o = __builtin_amdgcn_update_dpp(0, __float_as_int(prevreg), 0x121  , 0xf, 0xf, false);
    return __int_as_float(__builtin_amdgcn_update_dpp(o, __float_as_int(cur), 0x111  , 0xf, 0xf, false)); }
__device__ __forceinline__ float dpp_dn(float cur, float nextreg) {
    const int o = __builtin_amdgcn_update_dpp(0, __float_as_int(nextreg), 0x12F  , 0xf, 0xf, false);
    return __int_as_float(__builtin_amdgcn_update_dpp(o, __float_as_int(cur), 0x101  , 0xf, 0xf, false)); }
struct EpiHid {
    static constexpr bool PERM = true, AFTER_DRAIN = false;
    bf16_t* H; bf16_t* RAW; const float* cw; const float* cb;
    __device__ __forceinline__ void operator()(const f32x4 (&acc)[2][2][4][2], const pg8::Unit& u, int wr, int wc, int fr, int fq) const {
        const int rowb = u.pm * 256 + wr * 64, j0 = u.pn * 128 + wc * 32 + 8 * fq;
        f32x4 wab[2][3], wgb[2][3], bab[2], bgb[2];
#pragma unroll
        for (int n = 0; n < 2; ++n) { const int j = j0 + 4 * n; bab[n] = *(const f32x4*)(cb + j); bgb[n] = *(const f32x4*)(cb + DFF + j);
#pragma unroll
            for (int t = 0; t < 3; ++t) { wab[n][t] = *(const f32x4*)(cw + t * NUP + j); wgb[n][t] = *(const f32x4*)(cw + t * NUP + DFF + j); } }
#pragma unroll
        for (int n = 0; n < 2; ++n) { const int j = j0 + 4 * n;
            const f32x4 ba = bab[n], bg = bgb[n]; f32x4 wa[3], wg[3];
#pragma unroll
            for (int t = 0; t < 3; ++t) { wa[t] = wab[n][t]; wg[t] = wgb[n][t]; }
#pragma unroll
            for (int ai = 0; ai < 2; ++ai)
#pragma unroll
                for (int m = 0; m < 4; ++m) { const f32x4 ac = acc[ai][0][m][n], gc = acc[ai][1][m][n];
                    const f32x4 ap = acc[ai][0][m > 0 ? m - 1 : m][n], gp = acc[ai][1][m > 0 ? m - 1 : m][n], an = acc[ai][0][m < 3 ? m + 1 : m][n], gn = acc[ai][1][m < 3 ? m + 1 : m][n];
                    float hv[4];
#pragma unroll
                    for (int e = 0; e < 4; ++e) { const float a = ba[e] + wa[0][e] * dpp_up(ac[e], ap[e]) + wa[1][e] * ac[e] + wa[2][e] * dpp_dn(ac[e], an[e]);
                        const float g = bg[e] + wg[0][e] * dpp_up(gc[e], gp[e]) + wg[1][e] * gc[e] + wg[2][e] * dpp_dn(gc[e], gn[e]);
                        hv[e] = g * __builtin_amdgcn_rcpf(1.f + __expf(-g)) * a; }
                    const int lrow = m * 16 + fr; const int row = rowb + ai * 128 + lrow;
                    if (lrow != 0 && lrow != 63) { u32x2 o; o.x = pk2(hv[0], hv[1]); o.y = pk2(hv[2], hv[3]); *(u32x2*)(H + (size_t)row * DFF + j) = o; }
                    if (lrow <= 1 || lrow >= 62) { const int slot = lrow <= 1 ? lrow : lrow - 60; bf16_t* rp = RAW + ((size_t)(row >> 6) * 4 + slot) * NUP + j;
                        u32x2 ra, rg; ra.x = pk2(ac[0], ac[1]); ra.y = pk2(ac[2], ac[3]); rg.x = pk2(gc[0], gc[1]); rg.y = pk2(gc[2], gc[3]);
                        *(u32x2*)rp = ra; *(u32x2*)(rp + DFF) = rg; } } }
    }
};
struct EpiResid {
    static constexpr bool PERM = false, AFTER_DRAIN = false;
    const float* hin; float* hout; const float* cin; float* cout; const float* gl; const float* gc;
    __device__ __forceinline__ void operator()(const f32x4 (&acc)[2][2][4][2], const pg8::Unit& u, int wr, int wc, int fr, int fq) const {
        const bool isc = u.pm == 64; const float* src = isc ? cin : hin; float* dst = isc ? cout : hout; const float* gv = isc ? gc : gl;
        const int rbase = (isc ? 0 : u.pm * 256) + wr * 64 + fr, col0 = u.pn * 256 + wc * 32 + 4 * fq;
#pragma unroll
        for (int bj = 0; bj < 2; ++bj)
#pragma unroll
            for (int n = 0; n < 2; ++n) { const int col = col0 + bj * 128 + n * 16; const f32x4 g = *(const f32x4*)(gv + col); f32x4 h[2][4];
#pragma unroll
                for (int ai = 0; ai < 2; ++ai)
#pragma unroll
                    for (int m = 0; m < 4; ++m) h[ai][m] = *(const f32x4*)(src + (size_t)(rbase + ai * 128 + m * 16) * DM + col);
#pragma unroll
                for (int ai = 0; ai < 2; ++ai)
#pragma unroll
                    for (int m = 0; m < 4; ++m) *(f32x4*)(dst + (size_t)(rbase + ai * 128 + m * 16) * DM + col) = h[ai][m] + g * acc[ai][bj][m][n]; }
    }
};
struct MergeOrder {
    int nM, G, c, ntile;
    __device__ void init(int M, int G_, int c_) { nM = M / 256; G = G_; c = c_; ntile = nM * 8; }
    __device__ bool next(int i, pg8::Unit& u) const { const int t = (i >> 2) * G + c; if (t >= ntile) return false; const int br = i & 3; u.pm = br * 65 + (t >> 3); u.pn = br * 8 + (t & 7); return true; }
    __device__ __forceinline__ void a_ready(const pg8::Unit&) const {}
    __device__ __forceinline__ void done(const pg8::Unit&) const {}
};

namespace att {
constexpr int D = 128, NW = 8, QBLK = 32, KVBLK = 64;
constexpr float SCALE = 0.088388347648318440f;
constexpr float THR = 8.f;
constexpr size_t SHM_V = KVBLK * D * 2, SHM_K = KVBLK * D * 2, SHM_ATTN = 2 * SHM_V + 2 * SHM_K + NW * 64 * 4;
#define KSWZ(row, colB) ((row) * 256 + ((colB) ^ (((row) & 7) << 4)))
#define SBAR() __builtin_amdgcn_sched_barrier(0)
__device__ __forceinline__ int crow(int r, int hi) { return (r & 3) + 8 * (r >> 2) + 4 * hi; }
struct NaInfo { int r0, rs0, nloc; const float* bias; };
template <int MODE>
__device__ __forceinline__ void na_mask(f32x16& p0, f32x16& p1, int t, int wid, int r32, int hi, const NaInfo& na) {
    if (MODE == 0) return;
    if (t < 4) return;
    const int qr = na.r0 + (wid >> 1), qc = (wid & 1) * 32 + r32;
    const int kr = na.rs0 + (t - 4);
    const int rs = min(max(qr - 4, 0), 248);
    const bool rowok = (t - 4 < na.nloc) && kr >= rs && kr < rs + 8;
    if (!rowok) {
#pragma unroll
        for (int r = 0; r < 16; ++r) { p0[r] = -1e30f; p1[r] = -1e30f; }
    } else {
        const int cs = min(max(qc - 8, 0), 48);
        const int bidx = (kr - qr + 7) * 31 + 15 - qc;
#pragma unroll
        for (int r = 0; r < 16; ++r) { const int k0 = crow(r, hi), k1 = 32 + k0;
            const bool ok0 = k0 >= cs && k0 < cs + 16, ok1 = k1 >= cs && k1 < cs + 16;
            const float b0 = na.bias[ok0 ? bidx + k0 : 0], b1 = na.bias[ok1 ? bidx + k1 : 0];
            p0[r] = ok0 ? p0[r] + b0 : -1e30f; p1[r] = ok1 ? p1[r] + b1 : -1e30f;
            if ((r & 3) == 3) asm volatile("" ::: "memory"); }
    }
}
__device__ __forceinline__ void partialSM(f32x16& p0, f32x16& p1, float& m_reg, float& mn, float& alpha) {
    constexpr float C = SCALE * 1.4426950408889634f;
    float pmax = p0[0];
#pragma unroll
    for (int r = 1; r < 16; ++r) pmax = fmaxf(pmax, p0[r]);
#pragma unroll
    for (int r = 0; r < 16; ++r) pmax = fmaxf(pmax, p1[r]);
    { auto rr = __builtin_amdgcn_permlane32_swap(__float_as_uint(pmax), __float_as_uint(pmax), false, false);
      pmax = fmaxf(__uint_as_float(rr[0]), __uint_as_float(rr[1])); }
    if (__builtin_expect(__all(pmax - m_reg <= THR / SCALE), 1)) { mn = m_reg; alpha = 1.f; }
    else { mn = fmaxf(m_reg, pmax); alpha = __builtin_amdgcn_exp2f((m_reg - mn) * C); m_reg = mn; }
    float mnC = -mn * C;
#pragma unroll
    for (int r = 0; r < 16; ++r) p0[r] = fmaf(p0[r], C, mnC);
#pragma unroll
    for (int r = 0; r < 16; ++r) p1[r] = fmaf(p1[r], C, mnC);
#pragma unroll
    for (int r = 0; r < 16; ++r) p0[r] = __builtin_amdgcn_exp2f(p0[r]);
}
__device__ __forceinline__ void finishSM(f32x16& p0, f32x16& p1, float alpha, float& l_reg, bf16x8& pa0, bf16x8& pa1, bf16x8& pa2, bf16x8& pa3) {
#pragma unroll
    for (int r = 0; r < 16; ++r) p1[r] = __builtin_amdgcn_exp2f(p1[r]);
    float ps = 0;
#pragma unroll
    for (int r = 0; r < 16; ++r) ps += p0[r];
#pragma unroll
    for (int r = 0; r < 16; ++r) ps += p1[r];
    { auto rr = __builtin_amdgcn_permlane32_swap(__float_as_uint(ps), __float_as_uint(ps), false, false);
      ps = __uint_as_float(rr[0]) + __uint_as_float(rr[1]); }
    l_reg = l_reg * alpha + ps;
#define PK4(P, BASE, OUT) do { unsigned a0 = pk2(P[BASE + 0], P[BASE + 1]), a1 = pk2(P[BASE + 2], P[BASE + 3]);   \
    unsigned b0 = pk2(P[BASE + 4], P[BASE + 5]), b1 = pk2(P[BASE + 6], P[BASE + 7]);                              \
    auto r0 = __builtin_amdgcn_permlane32_swap(a0, b0, false, false); auto r1 = __builtin_amdgcn_permlane32_swap(a1, b1, false, false); \
    u32x4 w = {r0[0], r1[0], r0[1], r1[1]}; OUT = *reinterpret_cast<bf16x8*>(&w); } while (0)
    PK4(p0, 0, pa0); PK4(p0, 8, pa1); PK4(p1, 0, pa2); PK4(p1, 8, pa3);
#undef PK4
}
__device__ __forceinline__ void qkt(f32x16& p0, f32x16& p1, const bf16_t* Ks, const bf16x8* qr, int r32, int hi) {
    p0 = f32x16{}; p1 = f32x16{};
#pragma unroll
    for (int d0 = 0; d0 < 8; ++d0) { int cb = (d0 * 16 + hi * 8) * 2;
        bf16x8 b0 = *reinterpret_cast<const bf16x8*>((const char*)Ks + KSWZ(r32, cb));
        bf16x8 b1 = *reinterpret_cast<const bf16x8*>((const char*)Ks + KSWZ(32 + r32, cb));
        p0 = __builtin_amdgcn_mfma_f32_32x32x16_bf16(b0, qr[d0], p0, 0, 0, 0);
        p1 = __builtin_amdgcn_mfma_f32_32x32x16_bf16(b1, qr[d0], p1, 0, 0, 0); }
}
__device__ __forceinline__ int v_st(int k, int c) { const int kk = (k & ~0xC) | ((k & 4) << 1) | ((k & 8) >> 1); return ((kk >> 3) * 4 + (c >> 5)) * 512 + ((kk & 7) * 32 + (c & 31)) * 2; }
__device__ __forceinline__ int v_rd_base(int lane) { return ((lane & 3) << 3) | (((lane >> 2) & 3) << 6) | (((lane >> 4) & 1) << 5) | (((lane >> 5) & 1) << 8); }
constexpr int v_rd_off(int d0, int ks, int half) { return d0 * 512 + ks * 4096 + half * 2048; }
template <int OFF> __device__ __forceinline__ s16x4 tr_read(int vb) {
    s16x4 r; asm volatile("ds_read_b64_tr_b16 %0, %1 offset:%2" : "=&v"(r) : "v"(vb), "i"(OFF) : "memory"); return r;
}
template <int D0> __device__ __forceinline__ void pv_one(f32x16& od, int vb, bf16x8 pa0, bf16x8 pa1, bf16x8 pa2, bf16x8 pa3) {
    const s16x4 l0 = tr_read<v_rd_off(D0, 0, 0)>(vb), h0 = tr_read<v_rd_off(D0, 0, 1)>(vb), l1 = tr_read<v_rd_off(D0, 1, 0)>(vb), h1 = tr_read<v_rd_off(D0, 1, 1)>(vb);
    const s16x4 l2 = tr_read<v_rd_off(D0, 2, 0)>(vb), h2 = tr_read<v_rd_off(D0, 2, 1)>(vb), l3 = tr_read<v_rd_off(D0, 3, 0)>(vb), h3 = tr_read<v_rd_off(D0, 3, 1)>(vb);
    asm volatile("s_waitcnt lgkmcnt(0)" ::: "memory"); SBAR();
#define PK(L, H) (bf16x8){L[0], L[1], L[2], L[3], H[0], H[1], H[2], H[3]}
    od = __builtin_amdgcn_mfma_f32_32x32x16_bf16(pa0, PK(l0, h0), od, 0, 0, 0);
    od = __builtin_amdgcn_mfma_f32_32x32x16_bf16(pa1, PK(l1, h1), od, 0, 0, 0);
    od = __builtin_amdgcn_mfma_f32_32x32x16_bf16(pa2, PK(l2, h2), od, 0, 0, 0);
    od = __builtin_amdgcn_mfma_f32_32x32x16_bf16(pa3, PK(l3, h3), od, 0, 0, 0);
#undef PK
}
__device__ __forceinline__ void pv_d0(f32x16* o, int vb, bf16x8 pa0, bf16x8 pa1, bf16x8 pa2, bf16x8 pa3) {
    pv_one<0>(o[0], vb, pa0, pa1, pa2, pa3); pv_one<1>(o[1], vb, pa0, pa1, pa2, pa3); pv_one<2>(o[2], vb, pa0, pa1, pa2, pa3); pv_one<3>(o[3], vb, pa0, pa1, pa2, pa3);
}
template <int MODE, int SD>
__device__ __forceinline__ void attn_body(const bf16_t* __restrict__ Qb, const bf16_t* __restrict__ Kh, const bf16_t* __restrict__ Vh,
                                          bf16_t* __restrict__ Ob, int NT, char* lds, const NaInfo na) {
    constexpr int ldq = LDP, ldk = LDP, ldv = LDP, ldo = 512;
    const int tid = ltid(), wid = tid >> 6, lane = tid & 63, r32 = lane & 31, hi = lane >> 5;
    bf16_t* V_lds = (bf16_t*)lds; bf16_t* K_lds = (bf16_t*)(lds + 2 * SHM_V);
    float* ws = (float*)(lds + 2 * SHM_V + 2 * SHM_K) + wid * 64; float* li_l = ws; float* al_l = ws + 32;
    float m_reg = -1e30f, l_reg = 0; f32x16 o[4] = {}; bf16x8 qr[8];
    const bf16_t* Qw = Qb + (long)(wid * QBLK + r32) * ldq + hi * 8;
#pragma unroll
    for (int d0 = 0; d0 < 8; ++d0) qr[d0] = *reinterpret_cast<const bf16x8*>(Qw + d0 * 16);
    const int sr = tid >> 4, sc = (tid & 15) * 8, vst0 = v_st(sr, sc), vst1 = v_st(32 + sr, sc);
    const int vb0 = (int)(uintptr_t)V_lds + v_rd_base(lane);
    struct { bf16x8 vs0, vs1, ks0, ks1; } sr_[SD];
#define K0OF(t) (MODE == 0 ? (t) * 64 : ((t) < 4 ? SEQ + 64 * (t) : (na.rs0 + min((t) - 4, na.nloc - 1)) * 64))
#define SLOAD(i, t) do { const int k0_ = K0OF(t); sr_[i].vs0 = *(const bf16x8*)(&Vh[(long)(k0_ + sr) * ldv + sc]); sr_[i].vs1 = *(const bf16x8*)(&Vh[(long)(k0_ + 32 + sr) * ldv + sc]); \
    sr_[i].ks0 = *(const bf16x8*)(&Kh[(long)(k0_ + sr) * ldk + sc]); sr_[i].ks1 = *(const bf16x8*)(&Kh[(long)(k0_ + 32 + sr) * ldk + sc]); } while (0)
#define SWRITE(b, i) do { *(bf16x8*)((char*)V_lds + (b) * SHM_V + vst0) = sr_[i].vs0;          \
    *(bf16x8*)((char*)V_lds + (b) * SHM_V + vst1) = sr_[i].vs1; int kc = sc * 2;               \
    *(bf16x8*)((char*)K_lds + (b) * SHM_K + KSWZ(sr, kc)) = sr_[i].ks0;                       \
    *(bf16x8*)((char*)K_lds + (b) * SHM_K + KSWZ(32 + sr, kc)) = sr_[i].ks1; } while (0)
#define SWAIT() do { if (SD == 2) asm volatile("s_waitcnt vmcnt(4)" ::: "memory"); else asm volatile("s_waitcnt vmcnt(0)" ::: "memory"); } while (0)
#define RESC(a) do { if (__any((a) < 1.f)) { if (hi == 0) al_l[r32] = (a); asm volatile("s_waitcnt lgkmcnt(0)" ::: "memory"); \
    _Pragma("unroll") for (int d = 0; d < 4; ++d) _Pragma("unroll") for (int r = 0; r < 16; ++r) o[d][r] *= al_l[crow(r, hi)]; } } while (0)
    f32x16 pA0, pA1, pB0, pB1; float mnA, mnB, alA, alB; bf16x8 pa0, pa1, pa2, pa3;
    constexpr int SE = 0, SO = SD - 1;
    SLOAD(SE, 0); asm volatile("s_waitcnt vmcnt(0)" ::: "memory"); SWRITE(0, SE); __syncthreads();
    qkt(pA0, pA1, K_lds, qr, r32, hi); na_mask<MODE>(pA0, pA1, 0, wid, r32, hi, na); partialSM(pA0, pA1, m_reg, mnA, alA);
    SLOAD(SO, 1); if (SD == 2) { if (2 < NT) SLOAD(SE, 2); }
    SWAIT(); SWRITE(1, SO); __syncthreads();
    for (int j = 1; j + 1 < NT; j += 2) {
        SBAR(); qkt(pB0, pB1, (bf16_t*)((char*)K_lds + SHM_K), qr, r32, hi); na_mask<MODE>(pB0, pB1, j, wid, r32, hi, na);
        finishSM(pA0, pA1, alA, l_reg, pa0, pa1, pa2, pa3); SBAR();
        SLOAD(SO, j + SD); SBAR();
        pv_d0(o, vb0, pa0, pa1, pa2, pa3); partialSM(pB0, pB1, m_reg, mnB, alB);
        __syncthreads(); SWAIT(); SWRITE(0, SE);
        RESC(alB); __syncthreads();
        SBAR(); qkt(pA0, pA1, K_lds, qr, r32, hi); na_mask<MODE>(pA0, pA1, j + 1, wid, r32, hi, na);
        finishSM(pB0, pB1, alB, l_reg, pa0, pa1, pa2, pa3); SBAR();
        if (SD == 1 || j + 3 < NT) SLOAD(SE, j + 1 + SD); SBAR();
        pv_d0(o, vb0 + (int)SHM_V, pa0, pa1, pa2, pa3); partialSM(pA0, pA1, m_reg, mnA, alA);
        __syncthreads(); SWAIT(); SWRITE(1, SO);
        RESC(alA); __syncthreads();
    }
    SBAR(); qkt(pB0, pB1, (bf16_t*)((char*)K_lds + SHM_K), qr, r32, hi); na_mask<MODE>(pB0, pB1, NT - 1, wid, r32, hi, na);
    finishSM(pA0, pA1, alA, l_reg, pa0, pa1, pa2, pa3); SBAR();
    pv_d0(o, vb0, pa0, pa1, pa2, pa3); partialSM(pB0, pB1, m_reg, mnB, alB);
    __syncthreads(); RESC(alB);
    finishSM(pB0, pB1, alB, l_reg, pa0, pa1, pa2, pa3); SBAR();
    pv_d0(o, vb0 + (int)SHM_V, pa0, pa1, pa2, pa3);
    if (hi == 0) li_l[r32] = l_reg; asm volatile("s_waitcnt lgkmcnt(0)" ::: "memory");
    float rli[16];
#pragma unroll
    for (int r = 0; r < 16; ++r) rli[r] = __builtin_amdgcn_rcpf(li_l[crow(r, hi)]);
    bf16_t* Ow = Ob + (long)(wid * QBLK) * ldo;
#pragma unroll
    for (int r = 0; r < 16; ++r) { int orow = crow(r, hi);
#pragma unroll
        for (int d0 = 0; d0 < 4; ++d0) Ow[(long)orow * ldo + d0 * 32 + r32] = f2bf(o[d0][r] * rli[r]); }
    __syncthreads();
#undef SLOAD
#undef SWRITE
#undef SWAIT
#undef RESC
#undef K0OF
}
}
#define XB_TMO      128
#define XB_XCNT(j)  (256  + 64 * (j))
#define XB_XSUB(j)  (1280 + 64 * (j))
#define XB_XGEN(j)  (2304 + 64 * (j))
#define XB_TOP      3328
#define XB_TOPGEN   3392
#define XCD_BAR_WORDS 3456
#define XB_SPIN_CAP (1u << 18)

__device__ __forceinline__ unsigned xb_ld(unsigned* p)              { return __hip_atomic_load(p, __ATOMIC_RELAXED, __HIP_MEMORY_SCOPE_AGENT); }
__device__ __forceinline__ unsigned xb_add(unsigned* p, unsigned v) { return __hip_atomic_fetch_add(p, v, __ATOMIC_RELAXED, __HIP_MEMORY_SCOPE_AGENT); }
__device__ __forceinline__ unsigned xb_xcc_id() { return (unsigned)__builtin_amdgcn_s_getreg((3 << 11) | 20) & 0xFu; }
#define XB_SPIN(cond, bar) do { unsigned _sp = 0; while (cond) { __builtin_amdgcn_s_sleep(1); \
    if ((++_sp & 255u) == 0u) { if (xb_ld(&(bar)[XB_TMO])) break; if (_sp > XB_SPIN_CAP) { atomicAdd(&(bar)[XB_TMO], 1u); break; } } } } while (0)

struct XcdBarrier {
    unsigned* bar; unsigned x;
    volatile __attribute__((address_space(3))) unsigned* st;
};

__device__ __forceinline__ XcdBarrier xcd_barrier_post(unsigned* bar, volatile __attribute__((address_space(3))) unsigned* st) {
    XcdBarrier b; b.bar = bar; b.x = xb_xcc_id(); b.st = st;
    if (threadIdx.x == 0) (void)xb_add(&bar[XB_XCNT(b.x)], 1u);
    return b;
}
__device__ __forceinline__ void xcd_barrier_complete(unsigned* bar, unsigned x, unsigned& nloc, unsigned& nx) {
    const unsigned G = gridDim.x * gridDim.y * gridDim.z;
    unsigned sum, cnt, mine, sp = 0u;
    for (;;) {
        sum = 0u; cnt = 0u; mine = 0u;
#pragma unroll
        for (unsigned j = 0; j < 16; ++j) { const unsigned c = xb_ld(&bar[XB_XCNT(j)]); sum += c; cnt += (c > 0u) ? 1u : 0u; mine = (j == x) ? c : mine; }
        if (sum == G) break;
        __builtin_amdgcn_s_sleep(1);
        if ((++sp & 255u) == 0u) { if (xb_ld(&bar[XB_TMO])) break; if (sp > XB_SPIN_CAP) { atomicAdd(&bar[XB_TMO], 1u); break; } }
    }
    nloc = mine > 0u ? mine : 1u; nx = cnt > 0u ? cnt : 1u;
}

__device__ __forceinline__ void xcd_barrier(const XcdBarrier& b) {
    asm volatile("s_waitcnt vmcnt(0)" ::: "memory");
    __syncthreads();
    if (threadIdx.x == 0) {
        unsigned* bar = b.bar;
        __builtin_amdgcn_s_waitcnt(0);
        unsigned nloc = b.st[0], nx = b.st[1];
        if (nloc == 0u) { xcd_barrier_complete(bar, b.x, nloc, nx); b.st[0] = nloc; b.st[1] = nx; }
        const unsigned old = xb_add(&bar[XB_XSUB(b.x)], 1u);
        const unsigned gen = old / nloc;
        if (old + 1u == (gen + 1u) * nloc) {
            __builtin_amdgcn_fence(__ATOMIC_RELEASE, "agent");
            asm volatile("s_waitcnt vmcnt(0)" ::: "memory");
            const unsigned og = xb_add(&bar[XB_TOP], 1u);
            const unsigned tg = og / nx;
            if (og + 1u == (tg + 1u) * nx) xb_add(&bar[XB_TOPGEN], 1u);
            else XB_SPIN(xb_ld(&bar[XB_TOPGEN]) == tg, bar);
            __builtin_amdgcn_fence(__ATOMIC_ACQUIRE, "agent");
            xb_add(&bar[XB_XGEN(b.x)], 1u);
            asm volatile("s_waitcnt vmcnt(0)" ::: "memory");
        } else {
            XB_SPIN(xb_ld(&bar[XB_XGEN(b.x)]) == gen, bar);
            __builtin_amdgcn_fence(__ATOMIC_ACQUIRE, "agent");
            asm volatile("s_waitcnt vmcnt(0)" ::: "memory");
        }
    }
    __syncthreads();
}


#define WSP(T, off) ((T*)(p.ws + (off)))

__device__ __forceinline__ void transpose_item(const float* __restrict__ W, int K, int N, bf16_t* __restrict__ WT, int tile, float* scr, int gap_at, int gap, bool ag = false) {
    const int nblk = N / 32, kb = tile / nblk, nb = tile % nblk, k0 = kb * 64, n0 = nb * 32, tid = ltid();
    { const int kk = tid >> 3, n4 = (tid & 7) * 4; const f32x4 v = __builtin_nontemporal_load((const f32x4*)(W + (size_t)(k0 + kk) * N + n0 + n4));
      scr[kk * 33 + n4] = v[0]; scr[kk * 33 + n4 + 1] = v[1]; scr[kk * 33 + n4 + 2] = v[2]; scr[kk * 33 + n4 + 3] = v[3]; }
    __syncthreads();
    { const int n = tid >> 4, kc = (tid & 15) * 4; const int jj0 = n0 % DFF; const int nd = ag ? ((jj0 >> 7) * 256 + (n0 >= DFF ? 128 : 0) + (jj0 & 127) + n) : (n0 + n + ((n0 >= gap_at) ? gap : 0));
      u32x2 o; o.x = pk2(scr[kc * 33 + n], scr[(kc + 1) * 33 + n]); o.y = pk2(scr[(kc + 2) * 33 + n], scr[(kc + 3) * 33 + n]);
      *(u32x2*)(WT + (size_t)nd * K + k0 + kc) = o; }
    __syncthreads();
}
__device__ __forceinline__ void convert_weights(const Params& p, int layer, char* smem, int mode, int b0) {
    float* scr = (float*)smem;
    constexpr int T_IN = 32 * (INW / 32), T_BR = 8 * 64, T_OUT = 32 * 64, T_UP = 32 * (NUP / 32), T_DN = (DFF / 64) * 64;
    constexpr int TOT = T_IN + 4 * T_BR + T_OUT + T_UP + T_DN;
    const float* w_in = p.in[8] + (size_t)layer * DM * INW; const float* brw = p.in[26] + (size_t)layer * 4 * 512 * DM;
    const float* wout = p.in[27] + (size_t)layer * DM * DM; const float* wup = p.in[28] + (size_t)layer * DM * NUP; const float* wdn = p.in[31] + (size_t)layer * DFF * DM;
    const int nb = (int)gridDim.x - b0, mb = (int)blockIdx.x - b0;
    if (mb < 0) return;
    const int it_lo = mode == 2 ? TOT - T_DN : 0, it_hi = mode == 1 ? TOT - T_DN : TOT;
    for (int it = it_lo + mb; it < it_hi; it += nb) {
        int r = it;
        if (r < T_IN) { transpose_item(w_in, DM, INW, WSP(bf16_t, WS_WIN), r, scr, NMIX, NPM - NMIX); continue; } r -= T_IN;
        if (r < 4 * T_BR) { const int b = r / T_BR; transpose_item(brw + (size_t)b * 512 * DM, 512, DM, WSP(bf16_t, WS_WBR) + (size_t)b * DM * 512, r % T_BR, scr, 1 << 30, 0); continue; } r -= 4 * T_BR;
        if (r < T_OUT) { transpose_item(wout, DM, DM, WSP(bf16_t, WS_WOUT), r, scr, 1 << 30, 0); continue; } r -= T_OUT;
        if (r < T_UP) { transpose_item(wup, DM, NUP, WSP(bf16_t, WS_WUP), r, scr, 1 << 30, 0, true); continue; } r -= T_UP;
        transpose_item(wdn, DFF, DM, WSP(bf16_t, WS_WDN), r, scr, 1 << 30, 0);
    }
    if (mode == 2) return;
    u32x4* z = (u32x4*)(WSP(bf16_t, WS_WIN) + (size_t)NMIX * DM); const int nz = (NPM - NMIX) * DM * 2 / 16;
    unsigned z0 = 0u; asm volatile("" : "+v"(z0));
    for (int i = mb * NTH + ltid(); i < nz; i += nb * NTH) z[i] = (u32x4){z0, z0, z0, z0};
}
__device__ __forceinline__ void mod_partials(const Params& p, char* smem) {
    float* sv = (float*)smem; const int tid = ltid();
    { const float* cl = p.in[1]; const float* cc = p.in[3]; for (int i = tid; i < 2048; i += NTH) { sv[i] = siluf_(cl[i]); sv[2048 + i] = siluf_(cc[i]); } }
    __syncthreads();
    for (int it = blockIdx.x; it < 2 * KS * 6; it += gridDim.x) {
        const int layer = it / (KS * 6), ks = (it / 6) % KS, cgp = it % 6, col = cgp * 2048 + tid * 4;
        const float* w = p.in[4] + (size_t)layer * DM * 12288 + col; f32x4 a0 = {0, 0, 0, 0}, a1 = {0, 0, 0, 0};
#pragma unroll 8
        for (int k = ks * 128; k < ks * 128 + 128; ++k) { const f32x4 wv = __builtin_nontemporal_load((const f32x4*)(w + (size_t)k * 12288)); a0 += wv * sv[k]; a1 += wv * sv[2048 + k]; }
        float* mp = WSP(float, WS_MODP) + (size_t)((ks * 2 + layer) * 2) * 12288 + col;
        *(f32x4*)mp = a0; *(f32x4*)(mp + 12288) = a1;
    }
    __syncthreads();
}
__device__ __forceinline__ void xn_phase(const Params& p, int layer, int which, char* smem) {
    float* sv = (float*)smem; const int tid = ltid(), wid = tid >> 6, lane = tid & 63;
    const float* modp = WSP(float, WS_MODP); float* mod = WSP(float, WS_MOD); const float* ada_b = p.in[5];
    for (int i = tid; i < 8192; i += NTH) { const int v = i >> 12, w = (i >> 11) & 1, col = i & 2047, off = (which ? 6144 : 0) + w * 2048 + col; float val;
        if (which == 0 && layer == 0) { val = ada_b[layer * 12288 + off]; for (int ks = 0; ks < KS; ++ks) val += modp[(size_t)((ks * 2 + layer) * 2 + v) * 12288 + off]; }
        else val = mod[(layer * 2 + v) * 12288 + off];
        sv[(v * 2 + w) * 2048 + col] = val; }
    if (which == 0 && layer == 0) { const int gid = lbid() * NTH + tid;
        if (gid < 4 * 12288) { const int lv = gid / 12288, off = gid % 12288; float val = ada_b[(lv >> 1) * 12288 + off];
            for (int ks = 0; ks < KS; ++ks) val += modp[(size_t)(ks * 4 + lv) * 12288 + off]; mod[gid] = val; } }
    __syncthreads();
    const bool first = (layer == 0 && which == 0);
    const float* x_in = p.in[0]; const float* c_in = p.in[2]; const float* o_in = p.out; const float* hc_in = WSP(float, WS_HC); const float* n1 = p.in[6]; const float* n2 = p.in[7];
    const float* lsrc = first ? x_in : o_in; const float* csrc = first ? c_in : hc_in;
    const float* g = (which ? n2 : n1) + layer * DM; bf16_t* XN = WSP(bf16_t, WS_XN);
    const int nrows = (which == 1 && layer == 1) ? SEQ : MALL;
    for (int row = blockIdx.x * 8 + wid; row < nrows; row += gridDim.x * 8) {
        const bool isc = row >= SEQ; const float* src = isc ? csrc + (size_t)(row - SEQ) * DM : lsrc + (size_t)row * DM;
        const float* sh = sv + (isc ? 4096 : 0); const float* sc = sh + 2048;
        f32x4 v[8]; float ss = 0.f;
#pragma unroll
        for (int j = 0; j < 8; ++j) { v[j] = *(const f32x4*)(src + 4 * (lane + 64 * j)); ss += (v[j][0] * v[j][0] + v[j][1] * v[j][1]) + (v[j][2] * v[j][2] + v[j][3] * v[j][3]); }
        const float rinv = rsqrtf(wave_sum(ss) * (1.f / DM) + 1e-6f);
#pragma unroll
        for (int j = 0; j < 8; ++j) { const int c = 4 * (lane + 64 * j); const f32x4 gg = *(const f32x4*)(g + c); float y[4];
#pragma unroll
            for (int e = 0; e < 4; ++e) y[e] = v[j][e] * rinv * gg[e] * (1.f + sc[c + e]) + sh[c + e];
            u32x2 o; o.x = pk2(y[0], y[1]); o.y = pk2(y[2], y[3]); *(u32x2*)(XN + (size_t)row * DM + c) = o; }
    }
    __syncthreads();
}
__device__ __forceinline__ void final_norm(const Params& p) {
    const int wid = ltid() >> 6, lane = ltid() & 63; const float* g = p.in[32];
    for (int row = blockIdx.x * 8 + wid; row < SEQ; row += gridDim.x * 8) { float* src = p.out + (size_t)row * DM; f32x4 v[8]; float ss = 0.f;
#pragma unroll
        for (int j = 0; j < 8; ++j) { v[j] = *(const f32x4*)(src + 4 * (lane + 64 * j)); ss += (v[j][0] * v[j][0] + v[j][1] * v[j][1]) + (v[j][2] * v[j][2] + v[j][3] * v[j][3]); }
        const float rinv = rsqrtf(wave_sum(ss) * (1.f / DM) + 1e-6f);
#pragma unroll
        for (int j = 0; j < 8; ++j) { const int c = 4 * (lane + 64 * j); const f32x4 gg = *(const f32x4*)(g + c); *(f32x4*)(src + c) = v[j] * rinv * gg; }
    }
}
__device__ __forceinline__ void hid_fix_phase(const Params& p, int layer, int nrows) {
    const bf16_t* RAW = WSP(bf16_t, WS_U); bf16_t* H = WSP(bf16_t, WS_HID);
    const float* cw = p.in[29] + (size_t)layer * 3 * NUP; const float* cb = p.in[30] + (size_t)layer * NUP;
    constexpr int NCG = DFF / 8; const int total = (nrows / 64) * 2 * NCG;
    for (int it = lbid() * NTH + ltid(); it < total; it += gridDim.x * NTH) {
        const int e = it / NCG, c8 = (it % NCG) * 8, blk = e >> 1, which = e & 1, row = 64 * blk + (which ? 63 : 0);
        const bool isc = row >= SEQ; const int lo = isc ? SEQ : 0, hi = isc ? MALL : SEQ;
        const bool okp = which || row > lo, okn = !which || row + 1 < hi;
        const bf16_t* rc = RAW + ((size_t)blk * 4 + (which ? 3 : 0)) * NUP + c8;
        const bf16_t* rp = which ? RAW + ((size_t)blk * 4 + 2) * NUP + c8 : (okp ? RAW + ((size_t)(blk - 1) * 4 + 3) * NUP + c8 : rc);
        const bf16_t* rn = which ? (okn ? RAW + ((size_t)(blk + 1) * 4 + 0) * NUP + c8 : rc) : RAW + ((size_t)blk * 4 + 1) * NUP + c8;
        u32x4 ua[3], ug[3]; unsigned z0 = 0u; const u32x4 zz = {z0, z0, z0, z0};
        ua[0] = *(const u32x4*)rp; ug[0] = *(const u32x4*)(rp + DFF); if (!okp) { ua[0] = zz; ug[0] = zz; }
        ua[1] = *(const u32x4*)rc; ug[1] = *(const u32x4*)(rc + DFF);
        ua[2] = *(const u32x4*)rn; ug[2] = *(const u32x4*)(rn + DFF); if (!okn) { ua[2] = zz; ug[2] = zz; }
        u32x4 o;
#pragma unroll
        for (int e2 = 0; e2 < 4; ++e2) { float a0 = cb[c8 + 2 * e2], a1 = cb[c8 + 2 * e2 + 1], g0 = cb[DFF + c8 + 2 * e2], g1 = cb[DFF + c8 + 2 * e2 + 1];
#pragma unroll
            for (int t = 0; t < 3; ++t) { const unsigned xa = ua[t][e2], xg = ug[t][e2];
                a0 += cw[t * NUP + c8 + 2 * e2] * __uint_as_float(xa << 16); a1 += cw[t * NUP + c8 + 2 * e2 + 1] * __uint_as_float(xa & 0xffff0000u);
                g0 += cw[t * NUP + DFF + c8 + 2 * e2] * __uint_as_float(xg << 16); g1 += cw[t * NUP + DFF + c8 + 2 * e2 + 1] * __uint_as_float(xg & 0xffff0000u); }
            o[e2] = pk2(siluf_(g0) * a0, siluf_(g1) * a1); }
        *(u32x4*)(H + (size_t)row * DFF + c8) = o;
    }
}

__device__ __forceinline__ void qk_item(const Params& p, int layer, int item) {
    const int tid = ltid(), wid = tid >> 6, lane = tid & 63, row = item * 8 + wid; bf16_t* P = WSP(bf16_t, WS_P);
    const int hv = lane >> 3, sub = lane & 7, axis = sub >> 2, f0 = 8 * (sub & 3);
    if (hv >= 6) return;
    const bool lat = row < SEQ; const int pos = axis ? (row & 63) : (row >> 6);
    bf16_t* ptr = P + (size_t)row * LDP + (hv < 4 ? C_AQ + hv * 128 : C_AK + (hv - 4) * 128) + axis * 64 + f0;
    const float* g = (hv < 4 ? p.in[9] : p.in[10]) + layer * 128 + axis * 64 + f0;
    const u32x4 w1 = *(const u32x4*)ptr, w2 = *(const u32x4*)(ptr + 32);
    float x1[8], x2[8], ss = 0.f;
#pragma unroll
    for (int e2 = 0; e2 < 4; ++e2) { x1[2 * e2] = __uint_as_float(w1[e2] << 16); x1[2 * e2 + 1] = __uint_as_float(w1[e2] & 0xffff0000u); x2[2 * e2] = __uint_as_float(w2[e2] << 16); x2[2 * e2 + 1] = __uint_as_float(w2[e2] & 0xffff0000u); }
#pragma unroll
    for (int j = 0; j < 8; ++j) ss += x1[j] * x1[j] + x2[j] * x2[j];
    ss += __shfl_xor(ss, 1); ss += __shfl_xor(ss, 2); ss += __shfl_xor(ss, 4);
    const float rinv = rsqrtf(ss * (1.f / 128.f) + 1e-6f);
    float o1[8], o2[8];
#pragma unroll
    for (int j = 0; j < 8; ++j) { float c = 1.f, s = 0.f;
        if (lat) { const float invf = exp2f(-(float)(f0 + j) * (13.287712379549449f / 32.f)); sincos_((float)pos * invf, s, c); }
        const float a = x1[j] * rinv * g[j], b = x2[j] * rinv * g[32 + j];
        o1[j] = a * c - b * s; o2[j] = b * c + a * s; }
    u32x4 r1, r2;
#pragma unroll
    for (int e2 = 0; e2 < 4; ++e2) { r1[e2] = pk2(o1[2 * e2], o1[2 * e2 + 1]); r2[e2] = pk2(o2[2 * e2], o2[2 * e2 + 1]); }
    *(u32x4*)ptr = r1; *(u32x4*)(ptr + 32) = r2;
}
#define TSW(r, c) ((r) * 72 + (c))
__device__ __forceinline__ int gla_base(int dir, int c) { if (c < 4) return SEQ + (dir ? (3 - c) : c) * 64; const int m = dir ? 255 - (c - 4) : c - 4; return m * 64; }
__device__ __forceinline__ float logsig_(float x) { return fminf(x, 0.f) - log1pf(__expf(-fabsf(x))); }
template <bool ROWORD>
__device__ __forceinline__ void gla_gates(const Params& p, int layer, int dir, int head, int base, float* bb, float* as_, float* w2s, float* gb) {
    const int tid = ltid(); const bf16_t* P = WSP(bf16_t, WS_P);
    for (int i = tid; i < 1024; i += NTH) { const int ii = i >> 4, r = i & 15; const int row = base + ((dir && !ROWORD) ? 63 - ii : ii);
        as_[i] = bf2f(P[(size_t)row * LDP + C_CA + dir * 16 + r]);
        const int rr = i >> 6, d = i & 63; w2s[i] = p.in[12][((size_t)(layer * 2 + dir) * 16 + rr) * 256 + head * 64 + d]; }
    if (tid < 64) gb[tid] = p.in[13][(layer * 2 + dir) * 256 + head * 64 + tid];
    __syncthreads();
    { const int d = tid & 63, i0 = tid >> 6; float wcol[16]; const float g0 = gb[d];
#pragma unroll
      for (int r = 0; r < 16; ++r) wcol[r] = w2s[r * 64 + d];
#pragma unroll
      for (int k = 0; k < 8; ++k) { const int ii = i0 + 8 * k; float x = g0;
#pragma unroll
          for (int r4 = 0; r4 < 4; ++r4) { const f32x4 av = *(const f32x4*)(as_ + ii * 16 + 4 * r4);
#pragma unroll
              for (int e = 0; e < 4; ++e) x += av[e] * wcol[4 * r4 + e]; }
          bb[ii * 64 + d] = logsig_(x) * (1.f / 16.f); } }
    __syncthreads();
    { const int d = tid & 63, seg = tid >> 6; const bool rev = ROWORD && dir; float v[8]; float run = 0.f;
#pragma unroll
      for (int k = 0; k < 8; ++k) { const int s = seg * 8 + k, ii = rev ? 63 - s : s; run += bb[ii * 64 + d]; v[k] = run; }
      as_[seg * 64 + d] = run;
      __syncthreads();
      float off = 0.f;
#pragma unroll
      for (int s2 = 0; s2 < 7; ++s2) off += (s2 < seg) ? as_[s2 * 64 + d] : 0.f;
#pragma unroll
      for (int k = 0; k < 8; ++k) { const int s = seg * 8 + k, ii = rev ? 63 - s : s; bb[ii * 64 + d] = v[k] + off; } }
    __syncthreads();
}
__device__ __forceinline__ void gla_local_item(const Params& p, int layer, int item, char* smem) {
    const int tid = ltid(), wid = __builtin_amdgcn_readfirstlane(tid >> 6), lane = tid & 63, r32 = lane & 31, hi = lane >> 5;
    const int dir = item / (4 * NCHUNK), head = (item / NCHUNK) & 3, c = item % NCHUNK, base = gla_base(dir, c);
    bf16_t* ktT = (bf16_t*)smem; bf16_t* vT = ktT + 64 * 72; float* bb = (float*)(vT + 128 * 72); float* as_ = bb + 4096; float* w2s = as_ + 1024; float* gb = w2s + 1024;
    const bf16_t* P = WSP(bf16_t, WS_P);
    gla_gates<false>(p, layer, dir, head, base, bb, as_, w2s, gb);
    { const int ii = tid >> 3, d0 = (tid & 7) * 8; const bf16_t* pr = P + (size_t)(base + (dir ? 63 - ii : ii)) * LDP;
      const u32x4 kw = *(const u32x4*)(pr + C_CK + head * 64 + d0);
#pragma unroll
      for (int e2 = 0; e2 < 4; ++e2) { const int d = d0 + 2 * e2;
          ktT[TSW(d, ii)] = f2bf(__uint_as_float(kw[e2] << 16) * __expf(bb[63 * 64 + d] - bb[ii * 64 + d]));
          ktT[TSW(d + 1, ii)] = f2bf(__uint_as_float(kw[e2] & 0xffff0000u) * __expf(bb[63 * 64 + d + 1] - bb[ii * 64 + d + 1])); }
      const int e0 = (tid & 7) * 16; const u32x4 va = *(const u32x4*)(pr + C_CV + head * 128 + e0), vb = *(const u32x4*)(pr + C_CV + head * 128 + e0 + 8);
#pragma unroll
      for (int e2 = 0; e2 < 4; ++e2) { vT[TSW(e0 + 2 * e2, ii)] = (bf16_t)(va[e2] & 0xffffu); vT[TSW(e0 + 2 * e2 + 1, ii)] = (bf16_t)(va[e2] >> 16);
          vT[TSW(e0 + 8 + 2 * e2, ii)] = (bf16_t)(vb[e2] & 0xffffu); vT[TSW(e0 + 9 + 2 * e2, ii)] = (bf16_t)(vb[e2] >> 16); } }
    __syncthreads();
    const int mi = wid >> 2, ne = wid & 3; f32x16 acc = {};
#pragma unroll
    for (int ks = 0; ks < 4; ++ks) { const bf16x8 A = *(const bf16x8*)(ktT + TSW(32 * mi + r32, 16 * ks + 8 * hi)), B = *(const bf16x8*)(vT + TSW(32 * ne + r32, 16 * ks + 8 * hi));
        acc = __builtin_amdgcn_mfma_f32_32x32x16_bf16(A, B, acc, 0, 0, 0); }
    const size_t sidx = (size_t)((dir * 4 + head) * NCHUNK + c);
    float* GS = WSP(float, WS_GS) + sidx * 8192;
#pragma unroll
    for (int r = 0; r < 16; ++r) GS[(32 * mi + att::crow(r, hi)) * 128 + 32 * ne + r32] = acc[r];
    if (tid < 64) WSP(float, WS_GD)[sidx * 64 + tid] = __expf(bb[63 * 64 + tid]);
    __syncthreads();
}
__device__ __forceinline__ void gla_scan_item(const Params& p, int layer, int item) {
    const int dh = item >> 4, elem = (item & 15) * NTH + ltid(), d = elem >> 7;
    float* GS = WSP(float, WS_GS) + (size_t)dh * NCHUNK * 8192 + elem; const float* GD = WSP(float, WS_GD) + (size_t)dh * NCHUNK * 64 + d;
    float S = 0.f;
    for (int c = 0; c < NCHUNK; c += 13) { float L[13], Dv[13];
#pragma unroll
        for (int u = 0; u < 13; ++u) { L[u] = GS[(size_t)(c + u) * 8192]; Dv[u] = GD[(c + u) * 64]; }
#pragma unroll
        for (int u = 0; u < 13; ++u) { GS[(size_t)(c + u) * 8192] = S; S = Dv[u] * S + L[u]; } }
    __threadfence(); __syncthreads();
    if (ltid() == 0) __hip_atomic_fetch_add(WSP(unsigned, WS_CTL) + 64 * layer, 1u, __ATOMIC_RELEASE, __HIP_MEMORY_SCOPE_AGENT);
}
__device__ __forceinline__ void gla_scan_wait(const Params& p, int layer) {
    if (ltid() == 0) { while (__hip_atomic_load(WSP(unsigned, WS_CTL) + 64 * layer, __ATOMIC_ACQUIRE, __HIP_MEMORY_SCOPE_AGENT) < 128u) __builtin_amdgcn_s_sleep(8); }
    __syncthreads(); __threadfence();
}
__device__ __forceinline__ void gla_out_item(const Params& p, int layer, int item, char* smem) {
    const int tid = ltid(), wid = __builtin_amdgcn_readfirstlane(tid >> 6), lane = tid & 63, r32 = lane & 31, hi = lane >> 5;
    const int head = item & 3, m = item >> 2, rbase = m < 256 ? m * 64 : SEQ + (m - 256) * 64;
    bf16_t* qtb = (bf16_t*)smem; bf16_t* ktb = qtb + 64 * 72; bf16_t* attb = ktb + 64 * 72; bf16_t* vT = attb + 64 * 72; bf16_t* ST = vT + 128 * 72;
    float* bb = (float*)(ST + 128 * 72); float* as_ = bb + 4096; float* w2s = as_ + 1024; float* gb = w2s + 1024; float* obuf = (float*)smem;
    const bf16_t* P = WSP(bf16_t, WS_P);
    const int omi = wid >> 2, one = wid & 3; f32x16 acc = {};
    const int ii = tid >> 3, d0 = (tid & 7) * 8, e0 = (tid & 7) * 16; const bf16_t* pr = P + (size_t)(rbase + ii) * LDP;
    const u32x4 qw = *(const u32x4*)(pr + C_CQ + head * 64 + d0), kw = *(const u32x4*)(pr + C_CK + head * 64 + d0);
    { const u32x4 va = *(const u32x4*)(pr + C_CV + head * 128 + e0), vb = *(const u32x4*)(pr + C_CV + head * 128 + e0 + 8);
#pragma unroll
      for (int e2 = 0; e2 < 4; ++e2) { vT[TSW(e0 + 2 * e2, ii)] = (bf16_t)(va[e2] & 0xffffu); vT[TSW(e0 + 2 * e2 + 1, ii)] = (bf16_t)(va[e2] >> 16);
          vT[TSW(e0 + 8 + 2 * e2, ii)] = (bf16_t)(vb[e2] & 0xffffu); vT[TSW(e0 + 9 + 2 * e2, ii)] = (bf16_t)(vb[e2] >> 16); } }
    for (int dir = 0; dir < 2; ++dir) {
        const int c = m < 256 ? (dir ? 4 + 255 - m : 4 + m) : (dir ? 3 - (m - 256) : (m - 256));
        gla_gates<true>(p, layer, dir, head, rbase, bb, as_, w2s, gb);
        { u32x4 qo, ko;
#pragma unroll
          for (int e2 = 0; e2 < 4; ++e2) { const float b0 = bb[ii * 64 + d0 + 2 * e2], b1 = bb[ii * 64 + d0 + 2 * e2 + 1];
              qo[e2] = pk2(__uint_as_float(qw[e2] << 16) * 0.125f * __expf(b0), __uint_as_float(qw[e2] & 0xffff0000u) * 0.125f * __expf(b1));
              ko[e2] = pk2(__uint_as_float(kw[e2] << 16) * __expf(-b0), __uint_as_float(kw[e2] & 0xffff0000u) * __expf(-b1)); }
          *(u32x4*)(qtb + ii * 72 + d0) = qo; *(u32x4*)(ktb + ii * 72 + d0) = ko;
          const float* GS = WSP(float, WS_GS) + (size_t)((dir * 4 + head) * NCHUNK + c) * 8192 + ii * 128 + e0;
#pragma unroll
          for (int e4 = 0; e4 < 4; ++e4) { const f32x4 sv = *(const f32x4*)(GS + 4 * e4);
#pragma unroll
              for (int x = 0; x < 4; ++x) ST[TSW(e0 + 4 * e4 + x, ii)] = f2bf(sv[x]); } }
        __syncthreads();
        if (wid < 4) { const int mi = wid >> 1, nj = wid & 1; f32x16 t = {};
            if (dir ? (nj >= mi) : (nj <= mi)) {
#pragma unroll
                for (int ks = 0; ks < 4; ++ks) { const bf16x8 A = *(const bf16x8*)(qtb + (32 * mi + r32) * 72 + 16 * ks + 8 * hi), B = *(const bf16x8*)(ktb + (32 * nj + r32) * 72 + 16 * ks + 8 * hi);
                    t = __builtin_amdgcn_mfma_f32_32x32x16_bf16(A, B, t, 0, 0, 0); } }
#pragma unroll
            for (int r = 0; r < 16; ++r) { const int i = 32 * mi + att::crow(r, hi), j = 32 * nj + r32; const bool keep = dir ? (j >= i) : (j <= i); attb[i * 72 + j] = keep ? f2bf(t[r]) : (bf16_t)0; } }
        __syncthreads();
#pragma unroll
        for (int ks = 0; ks < 4; ++ks) { const bf16x8 A = *(const bf16x8*)(qtb + (32 * omi + r32) * 72 + 16 * ks + 8 * hi), B = *(const bf16x8*)(ST + TSW(32 * one + r32, 16 * ks + 8 * hi));
            acc = __builtin_amdgcn_mfma_f32_32x32x16_bf16(A, B, acc, 0, 0, 0); }
#pragma unroll
        for (int ks = 0; ks < 4; ++ks) { const bf16x8 A = *(const bf16x8*)(attb + (32 * omi + r32) * 72 + 16 * ks + 8 * hi), B = *(const bf16x8*)(vT + TSW(32 * one + r32, 16 * ks + 8 * hi));
            acc = __builtin_amdgcn_mfma_f32_32x32x16_bf16(A, B, acc, 0, 0, 0); }
        __syncthreads();
    }
#pragma unroll
    for (int r = 0; r < 16; ++r) obuf[(32 * omi + att::crow(r, hi)) * 132 + 32 * one + r32] = acc[r];
    __syncthreads();
    const int g = tid >> 5, e4 = tid & 31;
    const float* ng = p.in[14] + layer * 128 + 4 * e4; const f32x4 ngv = *(const f32x4*)ng;
    bf16_t* Y = WSP(bf16_t, WS_YS) + (size_t)2 * MALL * 512;
#pragma unroll
    for (int x = 0; x < 4; ++x) { const f32x4 o = *(const f32x4*)(obuf + (4 * g + x) * 132 + 4 * e4); float ss = (o[0] * o[0] + o[1] * o[1]) + (o[2] * o[2] + o[3] * o[3]);
#pragma unroll
        for (int off = 1; off < 32; off <<= 1) ss += __shfl_xor(ss, off);
        const float rinv = rsqrtf(ss * (1.f / 128.f) + 1e-6f); const int row = rbase + 4 * g + x;
        const u32x2 gw = *(const u32x2*)(P + (size_t)row * LDP + C_CG + head * 128 + 4 * e4);
        const float g0 = __uint_as_float(gw.x << 16), g1 = __uint_as_float(gw.x & 0xffff0000u), g2 = __uint_as_float(gw.y << 16), g3 = __uint_as_float(gw.y & 0xffff0000u);
        u32x2 w; w.x = pk2(o[0] * rinv * ngv[0] * siluf_(g0), o[1] * rinv * ngv[1] * siluf_(g1)); w.y = pk2(o[2] * rinv * ngv[2] * siluf_(g2), o[3] * rinv * ngv[3] * siluf_(g3));
        *(u32x2*)(Y + (size_t)row * 512 + head * 128 + 4 * e4) = w; }
    __syncthreads();
}
__device__ __forceinline__ void hyena_z_item(const Params& p, int layer, int item, char* smem) {
    const int tid = ltid(), cgp = tid & 63, rg = tid >> 6, ch0 = 8 * cgp, p0 = item * 32, r0 = p0 + 4 * rg;
    const bool isc = p0 >= SEQ; const int lo = isc ? SEQ : 0, hi = isc ? MALL : SEQ;
    const bf16_t* P = WSP(bf16_t, WS_P) + C_DU + ch0; const float* cw = p.in[15] + (size_t)layer * 3 * 1536; const float* cb = p.in[16] + (size_t)layer * 1536;
    bf16_t* zt = (bf16_t*)smem; bf16_t* xt = zt + 512 * 40;
    float val[3][4][8];
#pragma unroll
    for (int gch = 0; gch < 3; ++gch) { float w[3][8], b[8];
#pragma unroll
        for (int h = 0; h < 2; ++h) { const f32x4 bv = *(const f32x4*)(cb + gch * 512 + ch0 + 4 * h);
#pragma unroll
            for (int x = 0; x < 4; ++x) b[4 * h + x] = bv[x];
#pragma unroll
            for (int k = 0; k < 3; ++k) { const f32x4 wv = *(const f32x4*)(cw + k * 1536 + gch * 512 + ch0 + 4 * h);
#pragma unroll
                for (int x = 0; x < 4; ++x) w[k][4 * h + x] = wv[x]; } }
        u32x4 u[6];
#pragma unroll
        for (int t = 0; t < 6; ++t) { const int r = r0 + t - 1; const bool ok = r >= lo && r < hi; u[t] = *(const u32x4*)(P + (size_t)(ok ? r : r0) * LDP + gch * 512); if (!ok) { unsigned z0 = 0u; u[t] = (u32x4){z0, z0, z0, z0}; } }
#pragma unroll
        for (int rr = 0; rr < 4; ++rr)
#pragma unroll
            for (int e2 = 0; e2 < 4; ++e2) { float a0 = b[2 * e2], a1 = b[2 * e2 + 1];
#pragma unroll
                for (int k = 0; k < 3; ++k) { const unsigned x = u[rr + k][e2]; a0 += w[k][2 * e2] * __uint_as_float(x << 16); a1 += w[k][2 * e2 + 1] * __uint_as_float(x & 0xffff0000u); }
                val[gch][rr][2 * e2] = a0; val[gch][rr][2 * e2 + 1] = a1; } }
#pragma unroll
    for (int c8 = 0; c8 < 8; ++c8) { u32x2 zo, xo;
        zo.x = pk2(val[2][0][c8] * val[1][0][c8], val[2][1][c8] * val[1][1][c8]); zo.y = pk2(val[2][2][c8] * val[1][2][c8], val[2][3][c8] * val[1][3][c8]);
        xo.x = pk2(val[0][0][c8], val[0][1][c8]); xo.y = pk2(val[0][2][c8], val[0][3][c8]);
        *(u32x2*)(zt + (ch0 + c8) * 40 + 4 * rg) = zo; *(u32x2*)(xt + (ch0 + c8) * 40 + 4 * rg) = xo; }
    __syncthreads();
    bf16_t* ZT = WSP(bf16_t, WS_ZT); bf16_t* X0T = WSP(bf16_t, WS_X0T);
#pragma unroll
    for (int k = 0; k < 4; ++k) { const int piece = tid + NTH * k, ch = piece >> 2, part = piece & 3;
        *(u32x4*)(ZT + (size_t)ch * MALL + p0 + 8 * part) = *(const u32x4*)(zt + ch * 40 + 8 * part);
        *(u32x4*)(X0T + (size_t)ch * MALL + p0 + 8 * part) = *(const u32x4*)(xt + ch * 40 + 8 * part); }
    __syncthreads();
}
constexpr int HF_W = 24576;
__device__ __forceinline__ void hyena_filter_prep(const Params& p, int layer, char* smem) {
    const int tid = ltid(); float* w = (float*)(smem + HF_W);
    const float* w1 = p.in[17] + (size_t)layer * 33 * 64; const float* w2 = p.in[19] + (size_t)layer * 4096; const float* w3 = p.in[21] + (size_t)layer * 4096;
    for (int i = tid; i < 2112; i += NTH) w[i] = w1[i];
    for (int i = tid; i < 4096; i += NTH) { w[2112 + i] = w2[i]; w[2112 + 4096 + i] = w3[i]; }
    if (tid < 64) { w[10304 + tid] = p.in[18][layer * 64 + tid]; w[10368 + tid] = p.in[20][layer * 64 + tid]; w[10432 + tid] = p.in[22][layer * 64 + tid]; w[10496 + tid] = p.in[24][layer * 64 + tid]; }
    __syncthreads();
}
__device__ __forceinline__ void hyena_filter_item(const Params& p, int layer, int item, char* smem) {
    const int tid = ltid(); const bool isc = item >= 512; const int L = isc ? CTXL : SEQ, p0 = (isc ? item - 512 : item) * 32;
    float* zf = (float*)smem; float* h1 = zf + 32 * 33; float* h2 = h1 + 32 * 64;
    const float* w1 = (const float*)(smem + HF_W); const float* w2 = w1 + 2112; const float* w3 = w2 + 4096; const float* b1 = w3 + 4096; const float* b2 = b1 + 64; const float* b3 = b2 + 64; const float* fr = b3 + 64;
    const float* w4 = p.in[23] + (size_t)layer * 64 * 1024;
    for (int i = tid; i < 32 * 33; i += NTH) { const int q = i / 33, k = i % 33; const int pos = p0 + q; const float tt = (float)pos / (float)(L - 1), w = 6.283185307179586f * (float)pos / (float)L; float val;
        if (k == 0) val = tt; else { const int b = (k - 1) & 15; const float fb = 1e-4f + (float)b * ((15.f - 1e-4f) / 15.f); val = k <= 16 ? cos_(fb * w) : -sin_(fb * w); }
        zf[k * 32 + q] = val; }
    __syncthreads();
    { const int j = tid & 63, qg = tid >> 6; const float fj = fr[j];
      { f32x4 a = {b1[j], b1[j], b1[j], b1[j]};
#pragma unroll 3
        for (int k = 0; k < 33; ++k) a += *(const f32x4*)(zf + k * 32 + 4 * qg) * w1[k * 64 + j];
        f32x4 o; for (int x = 0; x < 4; ++x) o[x] = sin_(fj * a[x]); *(f32x4*)(h1 + j * 32 + 4 * qg) = o; }
      __syncthreads();
      { f32x4 a = {b2[j], b2[j], b2[j], b2[j]};
#pragma unroll 8
        for (int k = 0; k < 64; ++k) a += *(const f32x4*)(h1 + k * 32 + 4 * qg) * w2[k * 64 + j];
        f32x4 o; for (int x = 0; x < 4; ++x) o[x] = sin_(fj * a[x]); *(f32x4*)(h2 + j * 32 + 4 * qg) = o; }
      __syncthreads();
      { f32x4 a = {b3[j], b3[j], b3[j], b3[j]};
#pragma unroll 8
        for (int k = 0; k < 64; ++k) a += *(const f32x4*)(h2 + k * 32 + 4 * qg) * w3[k * 64 + j];
        f32x4 o; for (int x = 0; x < 4; ++x) o[x] = sin_(fj * a[x]); *(f32x4*)(h1 + j * 32 + 4 * qg) = o; } }
    __syncthreads();
    const int pg = tid & 3, cg = tid >> 2, pos0 = p0 + 8 * pg; float delta[4];
#pragma unroll
    for (int cc = 0; cc < 4; ++cc) delta[cc] = 3.0701134573253945f + (float)(4 * cg + cc) * ((15.350567286626973f - 3.0701134573253945f) / 511.f);
    bf16_t* FTb = WSP(bf16_t, WS_FT) + (size_t)layer * 512 * 32768; float* FTC = WSP(float, WS_FTC) + (size_t)layer * 2 * 512 * 256;
#pragma unroll 1
    for (int dir = 0; dir < 2; ++dir) { const int n0 = dir * 512 + 4 * cg; f32x4 a[8];
#pragma unroll
        for (int q = 0; q < 8; ++q) a[q] = (f32x4){0.f, 0.f, 0.f, 0.f};
#pragma unroll 1
        for (int k0 = 0; k0 < 64; k0 += 8) { f32x4 wv[8];
#pragma unroll
            for (int kk = 0; kk < 8; ++kk) wv[kk] = *(const f32x4*)(w4 + (k0 + kk) * 1024 + n0);
#pragma unroll
            for (int kk = 0; kk < 8; ++kk) { const f32x4 hA = *(const f32x4*)(h1 + (k0 + kk) * 32 + 8 * pg), hB = *(const f32x4*)(h1 + (k0 + kk) * 32 + 8 * pg + 4);
#pragma unroll
                for (int q = 0; q < 4; ++q) { a[q] += wv[kk] * hA[q]; a[4 + q] += wv[kk] * hB[q]; } } }
        f32x4 asum = {0.f, 0.f, 0.f, 0.f};
#pragma unroll
        for (int q = 0; q < 8; ++q) { const int pos = pos0 + q; const float tt = (float)pos / (float)(L - 1);
#pragma unroll
            for (int cc = 0; cc < 4; ++cc) { const float h = a[q][cc] * __expf(-tt * delta[cc]); asum[cc] += fabsf(h); a[q][cc] = (dir == 1 && pos == 0) ? 0.f : h;
                if (isc) FTC[(size_t)(n0 + cc) * 256 + pos] = h; } }
        if (!isc) {
#pragma unroll
            for (int cc = 0; cc < 4; ++cc) { u32x4 o;
#pragma unroll
                for (int w = 0; w < 4; ++w) o[w] = dir == 0 ? pk2(a[7 - 2 * w][cc], a[6 - 2 * w][cc]) : pk2(a[2 * w][cc], a[2 * w + 1][cc]);
                *(u32x4*)(FTb + (size_t)(4 * cg + cc) * 32768 + (dir == 0 ? SEQ - 8 - pos0 : SEQ + pos0)) = o; } }
#pragma unroll
        for (int cc = 0; cc < 4; ++cc) { asum[cc] += __shfl_xor(asum[cc], 1); asum[cc] += __shfl_xor(asum[cc], 2); }
        if (pg == 0) *(f32x4*)(WSP(float, WS_FSUM) + (size_t)layer * 520 * 1024 + (size_t)item * 1024 + n0) = asum; }
    __syncthreads();
}
struct HcB { bf16x8 b0, b1; };
__device__ __forceinline__ HcB hc_ldB(const char* Zs, int Jp, int roff, int r32, int hi) {
    const int Jc = min(max(Jp, -1), 16); const int s1p = 32 * Jc + r32 + roff + 64, sw = (s1p >> 2) & 3;
    HcB o; o.b0 = *(const bf16x8*)(Zs + s1p * 64 + ((hi ^ sw) << 4)); o.b1 = *(const bf16x8*)(Zs + s1p * 64 + (((2 + hi) ^ sw) << 4));
    return o;
}
__device__ __forceinline__ bf16x8 hc_ld8(const bf16_t* Gf, int a, bool s2, unsigned sel) {
    const u32x2* q = (const u32x2*)(Gf + (a & ~3)); const u32x2 w0 = q[0], w1 = q[1], w2 = q[2];
    const unsigned t0 = s2 ? w0.y : w0.x, t1 = s2 ? w1.x : w0.y, t2 = s2 ? w1.y : w1.x, t3 = s2 ? w2.x : w1.y, t4 = s2 ? w2.y : w2.x;
    u32x4 o; o.x = __builtin_amdgcn_perm(t1, t0, sel); o.y = __builtin_amdgcn_perm(t2, t1, sel); o.z = __builtin_amdgcn_perm(t3, t2, sel); o.w = __builtin_amdgcn_perm(t4, t3, sel);
    return *reinterpret_cast<bf16x8*>(&o);
}
__device__ __forceinline__ void hc_ldA(bf16x8& A0, bf16x8& A1, const bf16_t* Gf, int abase, int d) {
    if (d != 0) { const int a = abase - (d > 0 ? 1 : 0) - 32 * d; const bool s2 = (a & 2) != 0; const unsigned sel = (a & 1) ? 0x05040302u : 0x03020100u;
        A0 = hc_ld8(Gf, a, s2, sel); A1 = hc_ld8(Gf, a + 16, s2, sel); }
    else { const int tau0 = SEQ - abase;
#pragma unroll
        for (int j = 0; j < 8; ++j) { const int ta = tau0 - j, tb = tau0 - 16 - j; A0[j] = (short)Gf[SEQ - ta - (ta >= 0 ? 1 : 0)]; A1[j] = (short)Gf[SEQ - tb - (tb >= 0 ? 1 : 0)]; } }
}
template <bool ANTI, bool TRI>
__device__ __forceinline__ void hc_block(f32x16 (&acc)[4], HcB (&W)[4], bf16x8& A0, bf16x8& A1, const bf16_t* Gf, const char* Zs, int abase, int r, int tq, int Q, bool skip_first, int r32, int hi) {
#pragma unroll
    for (int qq = 0; qq < 4; ++qq) { const int q = 4 * Q + qq;
        const int dn = ANTI ? -(r + 32 * (q + 1)) : (r + 32 * (q + 1)); const int dnc = min(max(dn, -511), 511);
        bf16x8 nA0, nA1; hc_ldA(nA0, nA1, Gf, abase, dnc);
        const HcB nb = ANTI ? hc_ldB(Zs, 4 * tq + 4 + q, r, r32, hi) : hc_ldB(Zs, 4 * tq - q - 1, -r, r32, hi);
        if (!(skip_first && q == 0)) {
#pragma unroll
            for (int i = 0; i < 4; ++i) { const bool valid = TRI ? (ANTI ? (i <= 3 - qq) : (i >= qq)) : true;
                if (valid) { const int slot = ANTI ? ((i + qq) & 3) : ((i - qq) & 3);
                    acc[i] = __builtin_amdgcn_mfma_f32_32x32x16_bf16(A0, W[slot].b0, acc[i], 0, 0, 0); acc[i] = __builtin_amdgcn_mfma_f32_32x32x16_bf16(A1, W[slot].b1, acc[i], 0, 0, 0); } } }
        W[ANTI ? (qq & 3) : ((-qq - 1) & 3)] = nb; A0 = nA0; A1 = nA1;
    }
}
__device__ __forceinline__ void hc_wave(f32x16 (&acc)[4], const bf16_t* Gf, const char* Zs, int tq, int rc, int r32, int hi) {
    const int abase = SEQ - (r32 - 8 * hi);
#pragma unroll 1
    for (int k = 0; k < 16; ++k) { const int r = rc + 2 * k; HcB W[4]; bf16x8 A0, A1;
#pragma unroll
        for (int j = 0; j < 4; ++j) W[j] = hc_ldB(Zs, 4 * tq + j, -r, r32, hi);
        hc_ldA(A0, A1, Gf, abase, r);
#pragma unroll 1
        for (int Q = 0; Q < tq; ++Q) hc_block<false, false>(acc, W, A0, A1, Gf, Zs, abase, r, tq, Q, false, r32, hi);
        hc_block<false, true>(acc, W, A0, A1, Gf, Zs, abase, r, tq, tq, false, r32, hi);
#pragma unroll
        for (int j = 0; j < 4; ++j) W[j] = hc_ldB(Zs, 4 * tq + j, r, r32, hi);
        hc_ldA(A0, A1, Gf, abase, -r);
#pragma unroll 1
        for (int Q = 0; Q < 3 - tq; ++Q) hc_block<true, false>(acc, W, A0, A1, Gf, Zs, abase, r, tq, Q, (r == 0) && (Q == 0), r32, hi);
        hc_block<true, true>(acc, W, A0, A1, Gf, Zs, abase, r, tq, 3 - tq, (r == 0) && (tq == 3), r32, hi);
    }
}
__device__ __forceinline__ void hyena_conv_unit(const Params& p, int layer, int ch, char* smem) {
    const int tid = ltid(), wid = __builtin_amdgcn_readfirstlane(tid >> 6), lane = tid & 63, r32 = lane & 31, hi = lane >> 5;
    bf16_t* Gf = (bf16_t*)smem; char* Zs = smem + 65536; float* red = (float*)smem; float* sred = (float*)(smem + 65536 + 40960);
    { const u32x4* src = (const u32x4*)(WSP(bf16_t, WS_FT) + (size_t)layer * 512 * 32768 + (size_t)ch * 32768); u32x4* dst = (u32x4*)Gf;
#pragma unroll
      for (int q = 0; q < 8; ++q) dst[tid + q * NTH] = src[tid + q * NTH];
      const u32x4* zs = (const u32x4*)(WSP(bf16_t, WS_ZT) + (size_t)ch * MALL);
#pragma unroll
      for (int q = 0; q < 4; ++q) { const int ci = tid + q * NTH, s1p = (ci >> 2) + 64, c = ci & 3; *(u32x4*)(Zs + s1p * 64 + ((c ^ ((s1p >> 2) & 3)) << 4)) = zs[ci]; }
      { const int row = tid >> 2, c = tid & 3; const int s1p = row < 64 ? row : 512 + row; unsigned z0 = 0u; asm volatile("" : "+v"(z0)); *(u32x4*)(Zs + s1p * 64 + (c << 4)) = (u32x4){z0, z0, z0, z0}; }
      const float* fs = WSP(float, WS_FSUM) + (size_t)layer * 520 * 1024 + (size_t)tid * 1024; float a = fs[ch] + fs[512 + ch]; a = wave_sum(a); if (lane == 0) sred[wid] = a; }
    __syncthreads();
    float tot = 0.f;
#pragma unroll
    for (int w = 0; w < 8; ++w) tot += sred[w];
    const float inv = 1.f / tot;
    const int tq = wid >> 1, rc = wid & 1;
    f32x16 acc[4] = {};
    hc_wave(acc, Gf, Zs, tq, rc, r32, hi);
    __syncthreads();
    if (rc == 1) {
#pragma unroll
        for (int i = 0; i < 4; ++i)
#pragma unroll
            for (int r = 0; r < 16; ++r) red[((tq * 4 + i) * 16 + r) * 64 + lane] = acc[i][r]; }
    __syncthreads();
    if (rc == 0) {
#pragma unroll
        for (int i = 0; i < 4; ++i)
#pragma unroll
            for (int r = 0; r < 16; ++r) red[((tq * 4 + i) * 16 + r) * 64 + lane] += acc[i][r]; }
    __syncthreads();
    { int ch2 = ch, t2i = tid; asm volatile("" : "+v"(ch2), "+v"(t2i) :: "memory"); ch2 = __builtin_amdgcn_readfirstlane(ch2);
      const float bias = p.in[25][layer * 512 + ch2]; const bf16_t* X0 = WSP(bf16_t, WS_X0T) + (size_t)ch2 * MALL; bf16_t* Y = WSP(bf16_t, WS_YS) + (size_t)3 * MALL * 512 + ch2;
#pragma unroll 4
      for (int k = 0; k < 32; ++k) { const int idx = t2i + NTH * k, ln = idx & 63, r = (idx >> 6) & 15, J = idx >> 10;
          const int t1 = 32 * J + (ln & 31), t2 = att::crow(r, ln >> 5), pos = 32 * t1 + t2;
          const int t1p = t1 + 64; const float zv = bf2f(*(const bf16_t*)(Zs + t1p * 64 + (((t2 >> 3) ^ ((t1p >> 2) & 3)) << 4) + (t2 & 7) * 2));
          Y[(size_t)pos * 512] = f2bf(bf2f(X0[pos]) * (red[idx] * inv + zv * bias)); } }
    __syncthreads();
}
__device__ __forceinline__ void hyena_ctx_item(const Params& p, int layer, int item, char* smem) {
    const int tid = ltid(), cl = tid >> 8, ch = item * 2 + cl, t = tid & 255; float* sred = (float*)smem; float* F0s = sred + 16; float* F1s = F0s + 512; float* Zl = F1s + 512;
    if (tid < 16) { const int c2 = item * 2 + (tid >> 3), it = 512 + (tid & 7); const float* fsl = WSP(float, WS_FSUM) + (size_t)layer * 520 * 1024; sred[tid] = fsl[(size_t)it * 1024 + c2] + fsl[(size_t)it * 1024 + 512 + c2]; }
    const float* FTC = WSP(float, WS_FTC) + (size_t)layer * 2 * 512 * 256;
    F0s[tid] = FTC[(size_t)ch * 256 + t]; F1s[tid] = FTC[(size_t)(512 + ch) * 256 + t];
    const float zt = bf2f(WSP(bf16_t, WS_ZT)[(size_t)ch * MALL + SEQ + t]); Zl[tid] = zt;
    __syncthreads();
    float tot = 0.f; for (int w = 0; w < 8; ++w) tot += sred[cl * 8 + w];
    const float* f0 = F0s + cl * 256; const float* f1 = F1s + cl * 256; const float* zl = Zl + cl * 256; float a = 0.f;
#pragma unroll 8
    for (int s = 0; s < 256; ++s) { const float ka = f0[max(t - s, 0)], kb = f1[max(s - t, 0)]; a += zl[s] * ((t >= s) ? ka : kb); }
    const float x0 = bf2f(WSP(bf16_t, WS_X0T)[(size_t)ch * MALL + SEQ + t]);
    WSP(bf16_t, WS_YS)[(size_t)3 * MALL * 512 + (size_t)(SEQ + t) * 512 + ch] = f2bf(x0 * (a / tot + zt * p.in[25][layer * 512 + ch]));
    __syncthreads();
}

#ifndef REP_SYNC
#define REP_SYNC 0
#endif
#ifndef REP_XN
#define REP_XN 1
#endif
#ifndef REP_HZ
#define REP_HZ 1
#endif
#ifndef REP_MODP
#define REP_MODP 1
#endif
#ifndef REP_FIN
#define REP_FIN 1
#endif
#ifndef REP_QKD
#define REP_QKD 0
#endif
#ifndef REP_CONV
#define REP_CONV 1
#endif
#ifndef REP_PG
#define REP_PG 1
#endif
#ifndef REP_GQA
#define REP_GQA 1
#endif
#ifndef REP_NA
#define REP_NA 1
#endif
#ifndef REP_HC
#define REP_HC 1
#endif
#ifndef REP_GLA3
#define REP_GLA3 1
#endif
#ifndef REP_GLA1
#define REP_GLA1 1
#endif
#ifndef REP_HF
#define REP_HF 1
#endif
#ifndef REP_HID
#define REP_HID 1
#endif
#ifndef REP_UP
#define REP_UP 1
#endif
#ifndef REP_MERGE
#define REP_MERGE 1
#endif
template <class E, class S> __device__ __forceinline__ void run_gemm(char* smem, const bf16_t* A, const bf16_t* Bt, int M, int N, int K, const S& s, const E& e) {
    pg8::Gemm g{A, Bt, M, N, K};
    pg8::gemm_phase<E, S, true, true>((PG8_LAS unsigned char*)smem, g, s, e);
}

__global__ void __launch_bounds__(NTH, 2) mega(Params p_arg) {
    extern __shared__ __attribute__((aligned(16))) char smem[];
    cg::grid_group grid = cg::this_grid();
    const int bid = blockIdx.x, G = gridDim.x;
    volatile __attribute__((address_space(3))) unsigned* xst = (volatile __attribute__((address_space(3))) unsigned*)(smem + LDS_BYTES - 64);
    if (threadIdx.x < 2) xst[threadIdx.x] = 0u;
    __syncthreads();
    const XcdBarrier xbar = xcd_barrier_post((unsigned*)(p_arg.ws + WS_CTL + 1024), xst);
    int ph = 0;
    const int ph_lo = p_arg.ph_lo, ph_hi = p_arg.ph_hi;
    typedef const Params __attribute__((address_space(4)))* KP;
#define PHASE_BEGIN if (ph >= ph_lo && ph < ph_hi) { KP kp_ = (KP)__builtin_amdgcn_kernarg_segment_ptr(); asm volatile("" : "+s"(kp_) :: "memory"); Params p; __builtin_memcpy(&p, kp_, sizeof(Params)); \
    bf16_t* P = WSP(bf16_t, WS_P); const float* in_x = p.in[0]; const float* in_ctx = p.in[2]; float* outp = p.out; float* hcp = WSP(float, WS_HC); const float* mod = WSP(float, WS_MOD) + (size_t)layer * 2 * 12288; const int tid = ltid(); (void)P; (void)in_x; (void)in_ctx; (void)outp; (void)hcp; (void)mod; (void)tid;
#define PHASE_END   if (ph + 1 < ph_hi) { if (ph == 0) grid.sync(); else xcd_barrier(xbar); } } ++ph;
    { const int layer = 0; PHASE_BEGIN for (int rep = 0; rep < REP_MODP; ++rep) mod_partials(p, smem); for (int rep = 0; rep < REP_CONV; ++rep) convert_weights(p, 0, smem, 0, 0); PHASE_END }
#pragma unroll
    for (int layer = 0; layer < 2; ++layer) {
        const int Mr = layer == 0 ? MALL : SEQ;
        PHASE_BEGIN if (layer == 1) for (int rep = 0; rep < REP_CONV; ++rep) convert_weights(p, 1, smem, 2, 0); for (int rep = 0; rep < REP_XN; ++rep) xn_phase(p, layer, 0, smem); for (int rep = 0; rep < REP_SYNC; ++rep) xcd_barrier(xbar); PHASE_END
        PHASE_BEGIN for (int rep = 0; rep < REP_PG; ++rep) { pg8::StaticOrder S; S.init(MALL, LDP, G, bid); EpiStore E{P, LDP, NPM / 256}; run_gemm(smem, WSP(bf16_t, WS_XN), WSP(bf16_t, WS_WIN), MALL, LDP, DM, S, E); } PHASE_END
        PHASE_BEGIN
            for (int it = bid; it < MALL / 8; it += G) qk_item(p, layer, it);
            for (int rep = 0; rep < REP_GLA1; ++rep) for (int it = (bid + 64) % G; it < 8 * NCHUNK; it += G) gla_local_item(p, layer, it, smem);
            for (int rep = 0; rep < REP_HZ; ++rep) for (int it = (bid + 128) % G; it < MALL / 32; it += G) hyena_z_item(p, layer, it, smem);
            if (layer == 0) for (int rep = 0; rep < REP_HF; ++rep) { hyena_filter_prep(p, layer, smem); for (int it = (bid + 192) % G; it < 520; it += G) hyena_filter_item(p, layer, it, smem); }
        PHASE_END
        PHASE_BEGIN
            for (int it = (bid + 128) % G; it < 128; it += G) gla_scan_item(p, layer, it);
            bf16_t* YS = WSP(bf16_t, WS_YS);
            att::NaInfo na0{0, 0, 1, nullptr};
            for (int rep = 0; rep < REP_GQA; ++rep) for (int u = bid; u < 256; u += G) {
                const int xcd = u & 7, kvh = xcd >> 2, uu = (xcd & 3) * 32 + (u >> 3), head = 2 * kvh + (uu >> 6), qt = uu & 63;
                att::attn_body<0, 2>(P + (size_t)qt * 256 * LDP + C_AQ + head * 128, P + C_AK + kvh * 128, P + C_AV + kvh * 128,
                                  YS + (size_t)qt * 256 * 512 + head * 128, MALL / 64, smem, na0);
            }
            if (layer == 0) for (int u = (bid + 192) % G; u < 8; u += G) {
                const int head = u & 3;
                if (u < 4) att::attn_body<0, 2>(P + (size_t)SEQ * LDP + C_AQ + head * 128, P + (size_t)SEQ * LDP + C_AK + (head >> 1) * 128, P + (size_t)SEQ * LDP + C_AV + (head >> 1) * 128,
                                             YS + (size_t)SEQ * 512 + head * 128, 4, smem, na0);
                else att::attn_body<0, 2>(P + (size_t)SEQ * LDP + C_BQ + head * 128, P + (size_t)SEQ * LDP + C_BK + head * 128, P + (size_t)SEQ * LDP + C_BV + head * 128,
                                       YS + (size_t)MALL * 512 + (size_t)SEQ * 512 + head * 128, 4, smem, na0);
            }
            for (int rep = 0; rep < REP_NA; ++rep) for (int u = bid; u < 256; u += G) {
                const int head = u >> 6, qt = u & 63, r0 = qt * 4;
                float* bl = (float*)(smem + att::SHM_ATTN);
                { const int t_ = ltid(); if (t_ < 465) bl[t_] = p.in[11][(size_t)(layer * 4 + head) * 465 + t_] * (1.f / att::SCALE); }
                __syncthreads();
                const int rs0 = min(max(r0 - 4, 0), 248), rse = min(max(r0 + 3 - 4, 0), 248) + 8, nloc = rse - rs0;
                att::NaInfo na{r0, rs0, nloc, bl};
                att::attn_body<1, 1>(P + (size_t)qt * 256 * LDP + C_BQ + head * 128, P + C_BK + head * 128, P + C_BV + head * 128,
                                  YS + (size_t)MALL * 512 + (size_t)qt * 256 * 512 + head * 128, (4 + nloc + 1) & ~1, smem, na);
            }
            for (int rep = 0; rep < REP_HC; ++rep) for (int c0 = bid; c0 < 512; c0 += G) {
                const int cl = c0 & 255, ch = (G == 256) ? ((cl & 7) * 32 + (cl >> 3) + (c0 & 256)) : c0; hyena_conv_unit(p, layer, ch, smem); }
            if (layer == 0) for (int it = bid; it < 256; it += G) hyena_ctx_item(p, layer, it, smem);
            gla_scan_wait(p, layer);
            for (int rep = 0; rep < REP_GLA3; ++rep) for (int it = (bid + 64) % G; it < 4 * (layer == 0 ? 260 : 256); it += G) gla_out_item(p, layer, it, smem);
        PHASE_END
        PHASE_BEGIN for (int rep = 0; rep < REP_MERGE; ++rep) { MergeOrder S; S.init(Mr, G, bid); EpiMerge E{WSP(bf16_t, WS_MG), P + NPM}; run_gemm(smem, WSP(bf16_t, WS_YS), WSP(bf16_t, WS_WBR), 4 * MALL, 4 * DM, 512, S, E); }
            if (layer == 0) { const int b0 = G > 16 ? 8 : 0; if (bid >= b0) { hyena_filter_prep(p, 1, smem); for (int it = 512 - 1 - (bid - b0); it >= 0; it -= (G - b0)) hyena_filter_item(p, 1, it, smem); } }
        PHASE_END
        PHASE_BEGIN { pg8::StaticOrder S; S.init(Mr, DM, G, bid);
            EpiResid E{layer == 0 ? in_x : (const float*)outp, outp, layer == 0 ? in_ctx : (const float*)hcp, hcp, mod + 4096, mod + 12288 + 4096};
            run_gemm(smem, WSP(bf16_t, WS_MG), WSP(bf16_t, WS_WOUT), Mr, DM, DM, S, E); } PHASE_END
        PHASE_BEGIN for (int rep = 0; rep < REP_XN; ++rep) xn_phase(p, layer, 1, smem); PHASE_END
        PHASE_BEGIN for (int rep = 0; rep < REP_UP; ++rep) { pg8::StaticOrder S; S.init(Mr, NUP, G, bid); EpiHid E{WSP(bf16_t, WS_HID), WSP(bf16_t, WS_U), p.in[29] + (size_t)layer * 3 * NUP, p.in[30] + (size_t)layer * NUP}; run_gemm(smem, WSP(bf16_t, WS_XN), WSP(bf16_t, WS_WUP), Mr, NUP, DM, S, E); } PHASE_END
        PHASE_BEGIN hid_fix_phase(p, layer, Mr); PHASE_END
        PHASE_BEGIN { pg8::StaticOrder S; S.init(Mr, DM, G, bid);
            EpiResid E{outp, outp, hcp, hcp, mod + 10240, mod + 12288 + 10240};
            run_gemm(smem, WSP(bf16_t, WS_HID), WSP(bf16_t, WS_WDN), Mr, DM, DFF, S, E);
            if (layer == 0) convert_weights(p, 1, smem, 1, G > 16 ? 8 : 0); } PHASE_END
    }
    { const int layer = 0; PHASE_BEGIN for (int rep = 0; rep < REP_FIN; ++rep) final_norm(p); PHASE_END }
}

extern "C" void kernel_launch(void* const* d_in, const int* in_sizes, int n_in, void* d_out, int out_size, void* d_ws, size_t ws_size, hipStream_t stream) {
    static int grid_blocks = 0;
    if (grid_blocks == 0) {
        if (n_in != 33 || ws_size < WS_END) { fprintf(stderr, "kernel_launch: n_in %d ws %zu (need %zu)\n", n_in, ws_size, (size_t)WS_END); grid_blocks = -1; return; }
        int dev = 0, cus = 0, per_cu = 0;
        hipGetDevice(&dev); hipDeviceGetAttribute(&cus, hipDeviceAttributeMultiprocessorCount, dev);
        if (hipFuncSetAttribute((const void*)mega, hipFuncAttributeMaxDynamicSharedMemorySize, LDS_BYTES) != hipSuccess) { fprintf(stderr, "kernel_launch: LDS attribute failed\n"); grid_blocks = -1; return; }
        hipOccupancyMaxActiveBlocksPerMultiprocessor(&per_cu, (const void*)mega, NTH, LDS_BYTES);
        if (per_cu < 1) per_cu = 1;
        grid_blocks = cus * per_cu;
    }
    if (grid_blocks < 0) return;
    if (hipMemsetAsync((char*)d_ws + WS_CTL, 0, 16384, stream) != hipSuccess) { fprintf(stderr, "memset failed\n"); return; }
    Params p{};
    for (int i = 0; i < 33; ++i) p.in[i] = (const float*)d_in[i];
    p.out = (float*)d_out; p.ws = (unsigned char*)d_ws; p.ph_lo = 0; p.ph_hi = 1000;
    void* args[] = {&p};
    hipError_t e = hipLaunchCooperativeKernel((const void*)mega, dim3(grid_blocks), dim3(NTH), args, LDS_BYTES, stream);
    if (e != hipSuccess) fprintf(stderr, "cooperative launch failed: %s (grid %d)\n", hipGetErrorString(e), grid_blocks);
}
```
